# Optimizing an MI355X kernel written in HIP

```python
import jax, jax.numpy as jnp
from jax import lax
import numpy as np

D_MODEL = 2048
BATCH = 8
SEQ = 2048
DEPTH = 2

N_MIXERS = 2
N_FOX = (DEPTH + 1) // 2
N_SWA = DEPTH // 2
Q_BLOCK = 128

FOX_HEADS = 16
FOX_HEAD_DIM = D_MODEL // FOX_HEADS
FOX_WIDTH = FOX_HEADS * FOX_HEAD_DIM

SWA_HEAD_DIM = 64
SWA_Q_HEADS = D_MODEL // SWA_HEAD_DIM
SWA_KV_HEADS = SWA_Q_HEADS // 8
SWA_GROUP = SWA_Q_HEADS // SWA_KV_HEADS
SWA_WINDOW = 128
ROPE_THETA = 500000.0
ROPE_DIM = SWA_HEAD_DIM // 4

D_FF = 5632
CONV_WIDTH = 3

DEEPNORM_ALPHA = (2.0 * DEPTH) ** 0.25
DEEPNORM_BETA = (8.0 * DEPTH) ** -0.25
LN_EPS = 1e-5
ADA_SCALE = 0.2
MAX_POS_OFFSET = 4096

kernel_name = "hybrid_fox_swa_sink_convffn_deepnorm_adaln"


def layer_norm(x, g, b):
    xf = x.astype(jnp.float32)
    mu = jnp.mean(xf, axis=-1, keepdims=True)
    var = jnp.mean(jnp.square(xf - mu), axis=-1, keepdims=True)
    y = (xf - mu) * lax.rsqrt(var + LN_EPS)
    return (y * g.astype(jnp.float32) + b.astype(jnp.float32)).astype(x.dtype)


def rope_partial(t, pos):
    inv_freq = ROPE_THETA ** (-jnp.arange(0, ROPE_DIM, 2, dtype=jnp.float32) / ROPE_DIM)
    ang = pos.astype(jnp.float32)[..., None] * inv_freq
    cos = jnp.cos(ang)[:, :, None, :]
    sin = jnp.sin(ang)[:, :, None, :]
    tr = t[..., :ROPE_DIM].astype(jnp.float32)
    t1, t2 = tr[..., :ROPE_DIM // 2], tr[..., ROPE_DIM // 2:]
    rot = jnp.concatenate([t1 * cos - t2 * sin, t2 * cos + t1 * sin], axis=-1)
    return jnp.concatenate([rot.astype(t.dtype), t[..., ROPE_DIM:]], axis=-1)


def fox_attention(h, w_in, b_f, w_o):
    B, S, _ = h.shape
    H, dh = FOX_HEADS, FOX_HEAD_DIM
    proj = h @ w_in
    q = proj[..., :FOX_WIDTH].reshape(B, S, H, dh)
    k = proj[..., FOX_WIDTH:2 * FOX_WIDTH].reshape(B, S, H, dh)
    v = proj[..., 2 * FOX_WIDTH:3 * FOX_WIDTH].reshape(B, S, H, dh)
    f_logit = proj[..., 3 * FOX_WIDTH:] + b_f
    log_f = jax.nn.log_sigmoid(f_logit.astype(jnp.float32))
    cum = jnp.cumsum(log_f, axis=1).transpose(0, 2, 1)
    nb = S // Q_BLOCK
    q_blocks = q.reshape(B, nb, Q_BLOCK, H, dh).transpose(1, 0, 2, 3, 4)
    cq_blocks = cum.reshape(B, H, nb, Q_BLOCK).transpose(2, 0, 1, 3)
    key_pos = jnp.arange(S)
    scale = FOX_HEAD_DIM ** -0.5

    def one_block(args):
        qb, cqb, bi = args
        s = jnp.einsum('bqhd,bkhd->bhqk', qb, k).astype(jnp.float32) * scale
        s = s + cqb[..., None] - cum[:, :, None, :]
        q_pos = bi * Q_BLOCK + jnp.arange(Q_BLOCK)
        causal = key_pos[None, :] <= q_pos[:, None]
        s = jnp.where(causal, s, -jnp.inf)
        p = jax.nn.softmax(s, axis=-1).astype(v.dtype)
        return jnp.einsum('bhqk,bkhd->bqhd', p, v)

    o = lax.map(one_block, (q_blocks, cq_blocks, jnp.arange(nb)))
    o = o.transpose(1, 0, 2, 3, 4).reshape(B, S, FOX_WIDTH)
    return o @ w_o


def swa_attention(h, pos, w_in, sinks, w_o):
    B, S, _ = h.shape
    Hq, Hk, G, dh = SWA_Q_HEADS, SWA_KV_HEADS, SWA_GROUP, SWA_HEAD_DIM
    proj = h @ w_in
    q = proj[..., :Hq * dh].reshape(B, S, Hq, dh)
    k = proj[..., Hq * dh:(Hq + Hk) * dh].reshape(B, S, Hk, dh)
    v = proj[..., (Hq + Hk) * dh:].reshape(B, S, Hk, dh)
    q = rope_partial(q, pos)
    k = rope_partial(k, pos)
    nb = S // Q_BLOCK
    qb = q.reshape(B, nb, Q_BLOCK, Hk, G, dh)

    def band(t):
        tb = t.reshape(B, nb, Q_BLOCK, Hk, dh)
        prev = jnp.concatenate([jnp.zeros_like(tb[:, :1]), tb[:, :-1]], axis=1)
        return jnp.concatenate([prev, tb], axis=2)

    kb, vb = band(k), band(v)
    s = jnp.einsum('bnqhgd,bnkhd->bnhgqk', qb, kb).astype(jnp.float32) * (dh ** -0.5)
    qi = jnp.arange(Q_BLOCK)[:, None]
    kj = jnp.arange(2 * Q_BLOCK)[None, :]
    rel = qi + Q_BLOCK - kj
    key_abs = (jnp.arange(nb) * Q_BLOCK)[:, None] - Q_BLOCK + kj
    mask = (rel >= 0)[None] & (rel < SWA_WINDOW)[None] & (key_abs[:, None, :] >= 0)
    s = jnp.where(mask[None, :, None, None], s, -jnp.inf)
    sink = jnp.broadcast_to(sinks.astype(jnp.float32).reshape(1, 1, Hk, G, 1, 1), s.shape[:-1] + (1,))
    p = jax.nn.softmax(jnp.concatenate([s, sink], axis=-1), axis=-1)[..., :-1].astype(v.dtype)
    o = jnp.einsum('bnhgqk,bnkhd->bnqhgd', p, vb).reshape(B, S, Hq * dh)
    return o @ w_o


def conv_ffn(h, w_up, conv_w, conv_b, w_down):
    S = h.shape[1]
    u = h @ w_up
    up = jnp.pad(u, ((0, 0), (CONV_WIDTH - 1, 0), (0, 0)))
    u = sum(up[:, j:j + S] * conv_w[j] for j in range(CONV_WIDTH)) + conv_b
    g, val = u[..., :D_FF], u[..., D_FF:]
    return (jax.nn.silu(g) * val) @ w_down


def setup_inputs(seed: int = 0) -> dict:
    key = jax.random.key(seed)
    ks = jax.random.split(key, 20)
    f32 = jnp.float32
    n = lambda k, shape, s: (jax.random.normal(k, shape, f32) * s)
    D = D_MODEL
    x = n(ks[0], (BATCH, SEQ, D), 1.0)
    c = n(ks[1], (BATCH, D), 1.0)
    offset = jax.random.randint(ks[2], (BATCH, 1), 0, MAX_POS_OFFSET, dtype=jnp.int32)
    positions = (offset + jnp.arange(SEQ, dtype=jnp.int32)[None, :]).astype(jnp.int32)
    fox_w_in = n(ks[3], (N_FOX, D, 3 * FOX_WIDTH + FOX_HEADS), D ** -0.5)
    fox_b_f = n(ks[4], (N_FOX, FOX_HEADS), 0.1)
    fox_w_o = n(ks[5], (N_FOX, FOX_WIDTH, D), FOX_WIDTH ** -0.5 * DEEPNORM_BETA)
    swa_w_in = n(ks[6], (N_SWA, D, (SWA_Q_HEADS + 2 * SWA_KV_HEADS) * SWA_HEAD_DIM), D ** -0.5)
    swa_sinks = n(ks[7], (N_SWA, SWA_Q_HEADS), 0.5)
    swa_w_o = n(ks[8], (N_SWA, SWA_Q_HEADS * SWA_HEAD_DIM, D), (SWA_Q_HEADS * SWA_HEAD_DIM) ** -0.5 * DEEPNORM_BETA)
    ada_w = n(ks[9], (DEPTH, D, 6 * D), ADA_SCALE * D ** -0.5)
    ada_b = n(ks[10], (DEPTH, 6 * D), 0.02)
    ffn_w_up = n(ks[11], (DEPTH, D, 2 * D_FF), D ** -0.5)
    ffn_conv_w = n(ks[12], (DEPTH, CONV_WIDTH, 2 * D_FF), CONV_WIDTH ** -0.5)
    ffn_conv_b = n(ks[13], (DEPTH, 2 * D_FF), 0.02)
    ffn_w_down = n(ks[14], (DEPTH, D_FF, D), D_FF ** -0.5 * DEEPNORM_BETA)
    ln_mix_g = 1.0 + n(ks[15], (DEPTH, D), 0.02)
    ln_mix_b = n(ks[16], (DEPTH, D), 0.02)
    ln_ffn_g = 1.0 + n(ks[17], (DEPTH, D), 0.02)
    ln_ffn_b = n(ks[18], (DEPTH, D), 0.02)
    return {"x": x, "c": c, "positions": positions,
            "fox_w_in": fox_w_in, "fox_b_f": fox_b_f, "fox_w_o": fox_w_o,
            "swa_w_in": swa_w_in, "swa_sinks": swa_sinks, "swa_w_o": swa_w_o,
            "ada_w": ada_w, "ada_b": ada_b,
            "ffn_w_up": ffn_w_up, "ffn_conv_w": ffn_conv_w, "ffn_conv_b": ffn_conv_b, "ffn_w_down": ffn_w_down,
            "ln_mix_g": ln_mix_g, "ln_mix_b": ln_mix_b, "ln_ffn_g": ln_ffn_g, "ln_ffn_b": ln_ffn_b}


def reference(x, c, positions, fox_w_in, fox_b_f, fox_w_o, swa_w_in, swa_sinks, swa_w_o,
              ada_w, ada_b, ffn_w_up, ffn_conv_w, ffn_conv_b, ffn_w_down,
              ln_mix_g, ln_mix_b, ln_ffn_g, ln_ffn_b):
    c_act = jax.nn.silu(c)
    for i in range(DEPTH):
        mod = c_act @ ada_w[i] + ada_b[i]
        sh1, sc1, g1, sh2, sc2, g2 = jnp.split(mod[:, None, :], 6, axis=-1)
        h = x * (1.0 + sc1) + sh1
        j = i // N_MIXERS
        if i % N_MIXERS == 0:
            y = fox_attention(h, fox_w_in[j], fox_b_f[j], fox_w_o[j])
        else:
            y = swa_attention(h, positions, swa_w_in[j], swa_sinks[j], swa_w_o[j])
        x = layer_norm(DEEPNORM_ALPHA * x + (1.0 + g1) * y, ln_mix_g[i], ln_mix_b[i])
        h = x * (1.0 + sc2) + sh2
        y = conv_ffn(h, ffn_w_up[i], ffn_conv_w[i], ffn_conv_b[i], ffn_w_down[i])
        x = layer_norm(DEEPNORM_ALPHA * x + (1.0 + g2) * y, ln_ffn_g[i], ln_ffn_b[i])
    return x
```

```cpp
#include <hip/hip_runtime.h>
#include <hip/hip_cooperative_groups.h>
#include <cstdio>
#include <cstdint>
#include <cmath>
namespace cg = cooperative_groups;
__device__ __forceinline__ int opaque_tid() { int t = threadIdx.x; asm volatile("" : "+v"(t)); return t & 511; }
namespace pg8 {
#define PG8_LAS __attribute__((address_space(3)))
typedef unsigned short bf16_t;
typedef short bf16x8 __attribute__((ext_vector_type(8)));
typedef float f32x4 __attribute__((ext_vector_type(4)));
typedef unsigned u32x4 __attribute__((ext_vector_type(4)));
typedef unsigned u32x2 __attribute__((ext_vector_type(2)));
constexpr int BM = 256, BK = 64, HALF = 128, HTB = HALF * BK * 2  , STAGE_BYTES = 8 * HTB, NXCD = 8, WGM = 8;

__host__ __device__ __forceinline__ int lds_byte(int r, int c) { const int st = (r >> 4) * 2 + (c >> 5), rr = r & 15, cc = c & 31, ob = rr * 64 + cc * 2; return st * 1024 + (ob ^ (((ob >> 9) & 1) << 5)); }
__host__ __device__ __forceinline__ void stage_rc(int b, int& R, int& C) { const int st = b / 1024, sb = b % 1024, swz = sb ^ (((sb >> 9) & 1) << 5); R = (st >> 1) * 16 + swz / 64; C = (st & 1) * 32 + (swz % 64) / 2; }
__host__ __device__ __forceinline__ int perm32(int rho) { const int n = rho >> 4, i = rho & 15; return 8 * (i >> 2) + 4 * n + (i & 3); }

struct Unit { int pm, pn; };
struct Gemm { const bf16_t* A; const bf16_t* Bt; int M, N, K; };

struct StaticOrder {
    int nM, nN, nwg, G, c;
    __host__ __device__ void init(int M, int N, int G_, int c_) { nM = M / BM; nN = N / BM; nwg = nM * nN; G = G_; c = c_; }
    __host__ __device__ bool next(int i, Unit& u) const {
        const long L = (long)i * G + c; if (L >= nwg) return false;
        int wgid = (int)L; { const int q = nwg / NXCD, r = nwg % NXCD, xcd = wgid % NXCD, off = wgid / NXCD; wgid = (xcd < r ? xcd * (q + 1) : r * (q + 1) + (xcd - r) * q) + off; }
        const int nig = WGM * nN, gid = wgid / nig, fm = gid * WGM, gsz = (nM - fm) < WGM ? (nM - fm) : WGM;
        u.pm = fm + ((wgid % nig) % gsz); u.pn = (wgid % nig) / gsz; return true;
    }
    __device__ __forceinline__ void a_ready(const Unit&) const {}
    __device__ __forceinline__ void done(const Unit&) const {}
};

__device__ __forceinline__ unsigned cvt_pk_bf16(float lo, float hi) { unsigned r; asm volatile("v_cvt_pk_bf16_f32 %0, %1, %2" : "=v"(r) : "v"(lo), "v"(hi)); return r; }
struct EpiBf16 {
    static constexpr bool PERM = true, AFTER_DRAIN = false;
    bf16_t* O; int ldc; int split_cols; size_t split_stride;
    __device__ __forceinline__ void operator()(const f32x4 (&acc)[2][2][4][2], const Unit& u, int wr, int wc, int fr, int fq) const {
        const int row0 = u.pm * BM + wr * 64 + fr; int colt = u.pn * BM; bf16_t* base = O;
        if (split_cols) { const int t = colt / split_cols; base += (size_t)t * split_stride; colt -= t * split_cols; }
        const int col0 = colt + wc * 32 + 8 * fq;
#pragma unroll
        for (int ai = 0; ai < 2; ++ai)
#pragma unroll
            for (int m = 0; m < 4; ++m) { bf16_t* rowp = base + (size_t)(row0 + ai * HALF + m * 16) * ldc + col0;
#pragma unroll
                for (int bj = 0; bj < 2; ++bj) { const f32x4 v0 = acc[ai][bj][m][0], v1 = acc[ai][bj][m][1];
                    u32x4 w; w.x = cvt_pk_bf16(v0[0], v0[1]); w.y = cvt_pk_bf16(v0[2], v0[3]); w.z = cvt_pk_bf16(v1[0], v1[1]); w.w = cvt_pk_bf16(v1[2], v1[3]);
                    *(u32x4*)(rowp + bj * HALF) = w; } }
    }
};
struct EpiZ {
    static constexpr bool PERM = false, AFTER_DRAIN = false;
    const float* xres; float* z; const float* gate; float alpha;
    __device__ __forceinline__ void operator()(const f32x4 (&acc)[2][2][4][2], const Unit& u, int wr, int wc, int fr, int fq) const {
        const float* gv = gate + (size_t)(u.pm >> 3) * 12288;
        const int col0 = u.pn * BM + wc * 32 + 4 * fq;
        f32x4 g[2][2];
#pragma unroll
        for (int bj = 0; bj < 2; ++bj)
#pragma unroll
            for (int n = 0; n < 2; ++n) g[bj][n] = *(const f32x4*)(gv + col0 + bj * HALF + n * 16) + 1.0f;
#pragma unroll
        for (int ai = 0; ai < 2; ++ai)
#pragma unroll
            for (int m = 0; m < 4; ++m) { const size_t off = (size_t)(u.pm * BM + ai * HALF + wr * 64 + m * 16 + fr) * 2048 + col0;
#pragma unroll
                for (int bj = 0; bj < 2; ++bj)
#pragma unroll
                    for (int n = 0; n < 2; ++n) { const f32x4 xr = *(const f32x4*)(xres + off + bj * HALF + n * 16);
                        *(f32x4*)(z + off + bj * HALF + n * 16) = xr * alpha + g[bj][n] * acc[ai][bj][m][n]; }
                asm volatile("" ::: "memory"); }
    }
};
__device__ __forceinline__ float dpp_ror1(float v) { return __builtin_bit_cast(float, __builtin_amdgcn_update_dpp(0, __builtin_bit_cast(int, v), 0x121, 0xf, 0xf, false)); }
__device__ __forceinline__ float dpp_ror2(float v) { return __builtin_bit_cast(float, __builtin_amdgcn_update_dpp(0, __builtin_bit_cast(int, v), 0x122, 0xf, 0xf, false)); }
struct EpiUp {
    static constexpr bool PERM = true, AFTER_DRAIN = false;
    bf16_t* act; float* ubuf; const float* cw; const float* cb; PG8_LAS unsigned char* halo;
    __device__ __forceinline__ void operator()(const f32x4 (&acc)[2][2][4][2], const Unit& u, int wr, int wc, int fr, int fq) const {
        const int tcol = wc * 32 + 8 * fq;
        const int ch0 = u.pn * 128 + tcol;
        if (fr >= 14) {
#pragma unroll
            for (int ai = 0; ai < 2; ++ai) { const int blk = 2 * ai + wr;
                if (blk < 3) {
#pragma unroll
                    for (int bj = 0; bj < 2; ++bj)
#pragma unroll
                        for (int n = 0; n < 2; ++n) *(PG8_LAS f32x4*)(halo + (size_t)(((blk * 2 + (fr - 14)) * 256) + bj * 128 + tcol + 4 * n) * 4) = acc[ai][bj][3][n];
                } }
            if (wr == 1) {
#pragma unroll
                for (int bj = 0; bj < 2; ++bj)
#pragma unroll
                    for (int n = 0; n < 2; ++n) *(f32x4*)(ubuf + ((size_t)((u.pm * 4 + 2 + (fr - 14)) * 2 + bj)) * 5632 + ch0 + 4 * n) = acc[1][bj][3][n];
            }
        }
        if (wr == 0 && fr < 2) {
#pragma unroll
            for (int bj = 0; bj < 2; ++bj)
#pragma unroll
                for (int n = 0; n < 2; ++n) *(f32x4*)(ubuf + ((size_t)((u.pm * 4 + fr) * 2 + bj)) * 5632 + ch0 + 4 * n) = acc[0][bj][0][n];
        }
        asm volatile("s_waitcnt lgkmcnt(0)" ::: "memory"); __builtin_amdgcn_s_barrier(); asm volatile("" ::: "memory");
        const bool f1 = fr >= 1, f2 = fr >= 2;
#pragma unroll
        for (int n = 0; n < 2; ++n) {
            f32x4 w0[2], w1[2], w2[2], bb[2];
#pragma unroll
            for (int bj = 0; bj < 2; ++bj) { const int ci = bj * 5632 + ch0 + 4 * n;
                w0[bj] = *(const f32x4*)(cw + ci); w1[bj] = *(const f32x4*)(cw + 11264 + ci); w2[bj] = *(const f32x4*)(cw + 22528 + ci); bb[bj] = *(const f32x4*)(cb + ci); }
#pragma unroll
            for (int ai = 0; ai < 2; ++ai) { const int blk = 2 * ai + wr;
                f32x4 H[2];
#pragma unroll
                for (int bj = 0; bj < 2; ++bj) { H[bj] = (f32x4){0.f, 0.f, 0.f, 0.f};
                    if (blk > 0 && fr >= 14) H[bj] = *(const PG8_LAS f32x4*)(halo + (size_t)((((blk - 1) * 2 + (fr - 14)) * 256) + bj * 128 + tcol + 4 * n) * 4); }
#pragma unroll
                for (int m = 0; m < 4; ++m) {
                    f32x4 y[2];
#pragma unroll
                    for (int bj = 0; bj < 2; ++bj) { const f32x4 cur = acc[ai][bj][m][n]; f32x4 prv; if (m == 0) prv = H[bj]; else prv = acc[ai][bj][m > 0 ? m - 1 : 0][n];
#pragma unroll
                        for (int e = 0; e < 4; ++e) { const float c1 = dpp_ror1(cur[e]), p1 = dpp_ror1(prv[e]), c2 = dpp_ror2(cur[e]), p2 = dpp_ror2(prv[e]);
                            const float a1 = f1 ? c1 : p1, a2 = f2 ? c2 : p2;
                            y[bj][e] = fmaf(w2[bj][e], cur[e], fmaf(w1[bj][e], a1, fmaf(w0[bj][e], a2, bb[bj][e]))); } }
                    float o[4];
#pragma unroll
                    for (int e = 0; e < 4; ++e) { const float g = y[0][e]; const float sg = g * __builtin_amdgcn_rcpf(1.0f + __builtin_amdgcn_exp2f(-1.4426950408889634f * g)); o[e] = sg * y[1][e]; }
                    u32x2 w; w.x = cvt_pk_bf16(o[0], o[1]); w.y = cvt_pk_bf16(o[2], o[3]);
                    *(u32x2*)(act + (size_t)(u.pm * BM + ai * HALF + wr * 64 + m * 16 + fr) * 5632 + ch0 + 4 * n) = w;
                }
            }
            asm volatile("" ::: "memory");
        }
    }
};
template <class Epi, class Sched, bool ALIGN_EPI = false, bool SP2 = false>
__device__ __forceinline__ void gemm_phase(PG8_LAS unsigned char* lds, const Gemm g, const Sched& S, const Epi& E) {
    const int tid = opaque_tid(), wid = __builtin_amdgcn_readfirstlane(tid >> 6), lane = tid & 63, wr = wid >> 2, wc = wid & 3, fr = lane & 15, fq = lane >> 4;
    const int K = g.K, nt = K / BK;
    unsigned voffA[2], voffB[2];
#pragma unroll
    for (int i = 0; i < 2; ++i) { int R, C; stage_rc(tid * 16 + i * 8192, R, C); const int Rb = Epi::PERM ? ((R & ~31) + perm32(R & 31)) : R;
        voffA[i] = (unsigned)(R * K + C) * 2u; voffB[i] = (unsigned)(Rb * K + C) * 2u; }
    const size_t kstep = (size_t)(BK * 2);
    const size_t hstep = (size_t)HALF * K * 2;
    const size_t tstep = 2 * hstep;
    const unsigned ldsw = (unsigned)wid * 1024u;
    const int aoff = lds_byte(wr * 64 + fr, fq * 8), boff = lds_byte(wc * 32 + fr, fq * 8);
#define PG8_SA(b, h) (((b) * 2 + (h)) * HTB)
#define PG8_SB(b, h) ((4 + (b) * 2 + (h)) * HTB)
#define PG8_STAGE(bufoff, gbase, voff) do { _Pragma("unroll") for (int _i = 0; _i < 2; ++_i) \
        __builtin_amdgcn_global_load_lds((const unsigned*)((const char*)(gbase) + (voff)[_i]), (PG8_LAS unsigned*)(lds + (bufoff) + ldsw + _i * 8192), 16, 0, 0); } while (0)
#define PG8_LDA(dst, b, h) do { _Pragma("unroll") for (int m = 0; m < 4; ++m) _Pragma("unroll") for (int k = 0; k < 2; ++k) dst[m][k] = *(const PG8_LAS bf16x8*)(lds + PG8_SA(b, h) + aoff + m * 2048 + k * 1024); } while (0)
#define PG8_LDB(dst, b, h) do { _Pragma("unroll") for (int n = 0; n < 2; ++n) _Pragma("unroll") for (int k = 0; k < 2; ++k) dst[n][k] = *(const PG8_LAS bf16x8*)(lds + PG8_SB(b, h) + boff + n * 2048 + k * 1024); } while (0)
#define PG8_MMA(ai, bj, At, Bt) do { __builtin_amdgcn_s_setprio(1); _Pragma("unroll") for (int m = 0; m < 4; ++m) _Pragma("unroll") for (int n = 0; n < 2; ++n) _Pragma("unroll") for (int k = 0; k < 2; ++k) \
        acc[ai][bj][m][n] = __builtin_amdgcn_mfma_f32_16x16x32_bf16(Bt[n][k], At[m][k], acc[ai][bj][m][n], 0, 0, 0); __builtin_amdgcn_s_setprio(0); } while (0)
#define PG8_WAIT_V(n) asm volatile("s_waitcnt vmcnt(" #n ")" ::: "memory")
#define PG8_WAIT_L(n) asm volatile("s_waitcnt lgkmcnt(" #n ")" ::: "memory")
#define PG8_BAR __builtin_amdgcn_s_barrier()
#define PG8_SCHED __builtin_amdgcn_sched_barrier(0)
    Unit cur, nxt; int ui = 0;
    if (!S.next(0, cur)) return;
    f32x4 acc[2][2][4][2];
#pragma unroll
    for (int a = 0; a < 2; ++a)
#pragma unroll
        for (int b = 0; b < 2; ++b)
#pragma unroll
            for (int m = 0; m < 4; ++m)
#pragma unroll
                for (int n = 0; n < 2; ++n) acc[a][b][m][n] = (f32x4){0.f, 0.f, 0.f, 0.f};
    bf16x8 At[4][2], B0[2][2], B1[2][2];
    const char* cA = (const char*)g.A + (size_t)cur.pm * tstep; const char* cB = (const char*)g.Bt + (size_t)cur.pn * tstep;
    S.a_ready(cur);
    if constexpr (SP2) {
        PG8_STAGE(PG8_SB(0, 0), cB, voffB); PG8_STAGE(PG8_SB(0, 1), cB + hstep, voffB); PG8_STAGE(PG8_SA(0, 0), cA, voffA); PG8_STAGE(PG8_SA(0, 1), cA + hstep, voffA);
        if (wr == 1) PG8_BAR;
        PG8_WAIT_V(2); PG8_BAR;
        PG8_STAGE(PG8_SB(1, 0), cB + kstep, voffB); PG8_STAGE(PG8_SA(1, 0), cA + kstep, voffA); PG8_STAGE(PG8_SB(1, 1), cB + hstep + kstep, voffB);
        PG8_WAIT_V(6); PG8_BAR;
    } else {
        PG8_STAGE(PG8_SB(0, 0), cB, voffB); PG8_STAGE(PG8_SA(0, 0), cA, voffA); PG8_STAGE(PG8_SB(0, 1), cB + hstep, voffB); PG8_STAGE(PG8_SA(0, 1), cA + hstep, voffA);
        if (wr == 1) PG8_BAR;
        PG8_WAIT_V(4); PG8_BAR;
        PG8_STAGE(PG8_SB(1, 0), cB + kstep, voffB); PG8_STAGE(PG8_SA(1, 0), cA + kstep, voffA); PG8_STAGE(PG8_SB(1, 1), cB + hstep + kstep, voffB);
        PG8_WAIT_V(6); PG8_BAR;
    }
    for (;;) {
        const bool has_next = S.next(ui + 1, nxt);
        const char* nA = has_next ? (const char*)g.A + (size_t)nxt.pm * tstep : cA; const char* nB = has_next ? (const char*)g.Bt + (size_t)nxt.pn * tstep : cB;
        for (int t = 0; t < nt; t += 2) {
            const bool last = (t == nt - 2);
            const char* a1 = cA + (size_t)(t + 1) * kstep;
            const char* a2 = last ? nA : cA + (size_t)(t + 2) * kstep; const char* b2 = last ? nB : cB + (size_t)(t + 2) * kstep;
            const char* a3 = a2 + kstep; const char* b3 = b2 + kstep;
            if (last && has_next) S.a_ready(nxt);
            if constexpr (SP2) {
            PG8_LDB(B0, 0, 0); PG8_LDB(B1, 0, 1); PG8_SCHED; PG8_LDA(At, 0, 0); PG8_STAGE(PG8_SA(1, 1), a1 + hstep, voffA);
            PG8_WAIT_V(8); PG8_WAIT_L(0); PG8_BAR; PG8_MMA(0, 0, At, B0); PG8_MMA(0, 1, At, B1); PG8_BAR; PG8_SCHED;
            PG8_LDA(At, 0, 1); PG8_STAGE(PG8_SB(0, 0), b2, voffB); PG8_STAGE(PG8_SB(0, 1), b2 + hstep, voffB); PG8_STAGE(PG8_SA(0, 0), a2, voffA);
            PG8_WAIT_V(8); PG8_WAIT_L(0); PG8_BAR; PG8_MMA(1, 0, At, B0); PG8_MMA(1, 1, At, B1); PG8_BAR; PG8_SCHED;
            PG8_LDB(B0, 1, 0); PG8_LDB(B1, 1, 1); PG8_SCHED; PG8_LDA(At, 1, 0); PG8_STAGE(PG8_SA(0, 1), a2 + hstep, voffA);
            PG8_WAIT_V(8); PG8_WAIT_L(0); PG8_BAR; PG8_MMA(0, 0, At, B0); PG8_MMA(0, 1, At, B1); PG8_BAR; PG8_SCHED;
            PG8_LDA(At, 1, 1); PG8_STAGE(PG8_SB(1, 0), b3, voffB); PG8_STAGE(PG8_SB(1, 1), b3 + hstep, voffB); PG8_STAGE(PG8_SA(1, 0), a3, voffA);
            PG8_WAIT_V(8); PG8_WAIT_L(0); PG8_BAR; PG8_MMA(1, 0, At, B0); PG8_MMA(1, 1, At, B1); PG8_BAR; PG8_SCHED;
            } else {
            PG8_LDB(B0, 0, 0); PG8_SCHED; PG8_LDA(At, 0, 0); PG8_STAGE(PG8_SA(1, 1), a1 + hstep, voffA);
            PG8_WAIT_L(8); PG8_BAR; PG8_WAIT_L(0); PG8_MMA(0, 0, At, B0); PG8_BAR; PG8_SCHED;
            PG8_LDB(B1, 0, 1); PG8_STAGE(PG8_SB(0, 0), b2, voffB);
            PG8_BAR; PG8_WAIT_L(0); PG8_MMA(0, 1, At, B1); PG8_BAR;
            PG8_LDA(At, 0, 1); PG8_STAGE(PG8_SA(0, 0), a2, voffA);
            PG8_BAR; PG8_WAIT_L(0); PG8_MMA(1, 0, At, B0); PG8_BAR; PG8_SCHED;
            PG8_STAGE(PG8_SB(0, 1), b2 + hstep, voffB);
            PG8_WAIT_V(6); PG8_BAR; PG8_MMA(1, 1, At, B1); PG8_BAR;
            PG8_LDB(B0, 1, 0); PG8_SCHED; PG8_LDA(At, 1, 0); PG8_STAGE(PG8_SA(0, 1), a2 + hstep, voffA);
            PG8_WAIT_L(8); PG8_BAR; PG8_WAIT_L(0); PG8_MMA(0, 0, At, B0); PG8_BAR; PG8_SCHED;
            PG8_LDB(B1, 1, 1); PG8_STAGE(PG8_SB(1, 0), b3, voffB);
            PG8_BAR; PG8_WAIT_L(0); PG8_MMA(0, 1, At, B1); PG8_BAR;
            PG8_LDA(At, 1, 1); PG8_STAGE(PG8_SA(1, 0), a3, voffA);
            PG8_BAR; PG8_WAIT_L(0); PG8_MMA(1, 0, At, B0); PG8_BAR; PG8_SCHED;
            PG8_STAGE(PG8_SB(1, 1), b3 + hstep, voffB);
            PG8_WAIT_V(6); PG8_BAR; PG8_MMA(1, 1, At, B1); PG8_BAR;
            }
        }
        if constexpr (ALIGN_EPI) { if (wr == 0) PG8_BAR; }
        if constexpr (!Epi::AFTER_DRAIN) { E(acc, cur, wr, wc, fr, fq); S.done(cur); }
        if (!has_next) break;
#pragma unroll
        for (int a = 0; a < 2; ++a)
#pragma unroll
            for (int b = 0; b < 2; ++b)
#pragma unroll
                for (int m = 0; m < 4; ++m)
#pragma unroll
                    for (int n = 0; n < 2; ++n) acc[a][b][m][n] = (f32x4){0.f, 0.f, 0.f, 0.f};
        cur = nxt; cA = nA; cB = nB; ++ui;
        if constexpr (ALIGN_EPI) { if (wr == 1) PG8_BAR; }
    }
    PG8_WAIT_V(0);
    if constexpr (!ALIGN_EPI) { if (wr == 0) PG8_BAR; }
    PG8_BAR;
    if constexpr (Epi::AFTER_DRAIN) { E.fused(acc, cur, wr, wc, fr, fq, lds, wid, lane); S.done(cur); }
#undef PG8_SA
#undef PG8_SB
#undef PG8_STAGE
#undef PG8_LDA
#undef PG8_LDB
#undef PG8_MMA
#undef PG8_WAIT_V
#undef PG8_WAIT_L
#undef PG8_BAR
#undef PG8_SCHED
}
}
namespace fox {
typedef unsigned short bf16;
typedef short bf16x8 __attribute__((ext_vector_type(8)));
typedef short s16x4 __attribute__((ext_vector_type(4)));
typedef float f32x16 __attribute__((ext_vector_type(16)));
typedef float f32x4 __attribute__((ext_vector_type(4)));
typedef unsigned u32x4 __attribute__((ext_vector_type(4)));
#define FLAS __attribute__((address_space(3)))
constexpr int D = 128, PITCH = 2048, SEQ = 2048;
constexpr float SCALE = 0.08838834764831845f, INV_SCALE = 11.313708498984761f, THR = 8.f;
constexpr int NW = 8, QBLK = 32, KVBLK = 64, QB = NW * QBLK;
constexpr int SHM_V = KVBLK * D * 2, SHM_K = KVBLK * D * 2;
constexpr int LDS_WS = 2 * SHM_V + 2 * SHM_K, LDS_KB = LDS_WS + NW * 64 * 4, LDS_WT = LDS_KB + 4 * SEQ * 4, LDS_BYTES = LDS_WT + 64;
constexpr int WBIG = 1 << 30;
#define KSWZ(row, colB) ((row) * 256 + ((colB) ^ (((row) & 7) << 4)))
#define SBAR() __builtin_amdgcn_sched_barrier(0)
__device__ __forceinline__ int v_st(int k, int c) { const int kk = (k & ~0xC) | ((k & 4) << 1) | ((k & 8) >> 1); return ((kk >> 3) * 4 + (c >> 5)) * 512 + ((kk & 7) * 32 + (c & 31)) * 2; }
__device__ __forceinline__ int v_rd_base(int lane) { return ((lane & 3) << 3) | (((lane >> 2) & 3) << 6) | (((lane >> 4) & 1) << 5) | (((lane >> 5) & 1) << 8); }
constexpr int v_rd_off(int d0, int ks, int half) { return d0 * 512 + ks * 4096 + half * 2048; }
__device__ __forceinline__ int crow(int r, int hi) { return (r & 3) + 8 * (r >> 2) + 4 * hi; }
__device__ __forceinline__ unsigned cvtpk(float lo, float hi) { unsigned r; asm volatile("v_cvt_pk_bf16_f32 %0, %1, %2" : "=v"(r) : "v"(lo), "v"(hi)); return r; }
__device__ __forceinline__ bf16x8 load8(const bf16* p) { return *reinterpret_cast<const bf16x8*>(p); }
__device__ __forceinline__ void mask_tile(f32x16& p0, f32x16& p1, int dq, unsigned W) {
    const float NEG = -__builtin_inff();
#pragma unroll
    for (int r = 0; r < 16; ++r) {
        const int c = (r & 3) + 8 * (r >> 2);
        if ((unsigned)(dq - c) >= W) p0[r] = NEG;
        if ((unsigned)(dq - c - 32) >= W) p1[r] = NEG;
    }
}
__device__ __forceinline__ void partialSM(f32x16& p0, f32x16& p1, float& m_reg, float& mn, float& alpha) {
    float pmax = p0[0];
#pragma unroll
    for (int r = 1; r < 16; ++r) pmax = fmaxf(pmax, p0[r]);
#pragma unroll
    for (int r = 0; r < 16; ++r) pmax = fmaxf(pmax, p1[r]);
    { auto rr = __builtin_amdgcn_permlane32_swap(__float_as_uint(pmax), __float_as_uint(pmax), false, false);
      pmax = fmaxf(__uint_as_float(rr[0]), __uint_as_float(rr[1])); }
    constexpr float C2 = 1.4426950408889634f * SCALE;
    if (__builtin_expect(__all((pmax - m_reg) * SCALE <= THR), 1)) { mn = m_reg; alpha = 1.f; }
    else { mn = fmaxf(m_reg, pmax); alpha = __builtin_amdgcn_exp2f((m_reg - mn) * C2); m_reg = mn; }
    const float mnL = -mn * C2;
#pragma unroll
    for (int r = 0; r < 16; ++r) p0[r] = fmaf(p0[r], C2, mnL);
#pragma unroll
    for (int r = 0; r < 16; ++r) p1[r] = fmaf(p1[r], C2, mnL);
#pragma unroll
    for (int r = 0; r < 16; ++r) p0[r] = __builtin_amdgcn_exp2f(p0[r]);
}
#define PK4(P, B_, OUT) do { unsigned a0 = cvtpk(P[B_+0], P[B_+1]), a1 = cvtpk(P[B_+2], P[B_+3]);                          \
        unsigned b0 = cvtpk(P[B_+4], P[B_+5]), b1 = cvtpk(P[B_+6], P[B_+7]);                                             \
        auto r0 = __builtin_amdgcn_permlane32_swap(a0, b0, false, false); auto r1 = __builtin_amdgcn_permlane32_swap(a1, b1, false, false); \
        u32x4 w = {r0[0], r1[0], r0[1], r1[1]}; OUT = *reinterpret_cast<bf16x8*>(&w); } while (0)
__device__ __forceinline__ void finishSM(f32x16& p0, f32x16& p1, float alpha, float& l_reg, bf16x8& pa0, bf16x8& pa1, bf16x8& pa2, bf16x8& pa3) {
#pragma unroll
    for (int r = 0; r < 16; ++r) p1[r] = __builtin_amdgcn_exp2f(p1[r]);
    float ps = 0;
#pragma unroll
    for (int r = 0; r < 16; ++r) ps += p0[r];
#pragma unroll
    for (int r = 0; r < 16; ++r) ps += p1[r];
    { auto rr = __builtin_amdgcn_permlane32_swap(__float_as_uint(ps), __float_as_uint(ps), false, false);
      ps = __uint_as_float(rr[0]) + __uint_as_float(rr[1]); }
    l_reg = l_reg * alpha + ps;
    PK4(p0, 0, pa0); PK4(p0, 8, pa1); PK4(p1, 0, pa2); PK4(p1, 8, pa3);
}
template <int KB>
__device__ __forceinline__ void qkt(f32x16& p0, f32x16& p1, const char* K_lds, int r32, int hi, const bf16x8* qr, const FLAS float* kbp) {
#pragma unroll
    for (int g = 0; g < 4; ++g) { const f32x4 v0 = *(const FLAS f32x4*)(kbp + 8 * g), v1 = *(const FLAS f32x4*)(kbp + 32 + 8 * g);
#pragma unroll
        for (int e = 0; e < 4; ++e) { p0[4 * g + e] = v0[e]; p1[4 * g + e] = v1[e]; } }
    const char* kb[4];
#pragma unroll
    for (int dd = 0; dd < 4; ++dd) kb[dd] = K_lds + KB * SHM_K + KSWZ(r32, (dd * 16 + hi * 8) * 2);
#pragma unroll
    for (int d0 = 0; d0 < 8; ++d0) { const char* a = kb[d0 & 3] + (d0 >> 2) * 128;
        bf16x8 b0 = *reinterpret_cast<const bf16x8*>(a);
        bf16x8 b1 = *reinterpret_cast<const bf16x8*>(a + 32 * 256);
        p0 = __builtin_amdgcn_mfma_f32_32x32x16_bf16(b0, qr[d0], p0, 0, 0, 0);
        p1 = __builtin_amdgcn_mfma_f32_32x32x16_bf16(b1, qr[d0], p1, 0, 0, 0); }
}
template <int VB>
__device__ __forceinline__ void pv_tile(f32x16* o, int vb0, bf16x8 pa0, bf16x8 pa1, bf16x8 pa2, bf16x8 pa3) {
#define TRRD(dst, off) asm volatile("ds_read_b64_tr_b16 %0, %1 offset:%2" : "=&v"(dst) : "v"(vb0), "i"(off) : "memory")
#define PV_D0(d0) do { s16x4 l0, l1, l2, l3, h0, h1, h2, h3; constexpr int b_ = VB * SHM_V + v_rd_off(d0, 0, 0); \
        TRRD(l0, b_); TRRD(h0, b_ + 2048); TRRD(l1, b_ + 4096); TRRD(h1, b_ + 6144); TRRD(l2, b_ + 8192); TRRD(h2, b_ + 10240); TRRD(l3, b_ + 12288); TRRD(h3, b_ + 14336); \
        asm volatile("s_waitcnt lgkmcnt(0)" ::: "memory"); SBAR(); \
        o[d0] = __builtin_amdgcn_mfma_f32_32x32x16_bf16(pa0, (bf16x8){l0[0], l0[1], l0[2], l0[3], h0[0], h0[1], h0[2], h0[3]}, o[d0], 0, 0, 0);   \
        o[d0] = __builtin_amdgcn_mfma_f32_32x32x16_bf16(pa1, (bf16x8){l1[0], l1[1], l1[2], l1[3], h1[0], h1[1], h1[2], h1[3]}, o[d0], 0, 0, 0);   \
        o[d0] = __builtin_amdgcn_mfma_f32_32x32x16_bf16(pa2, (bf16x8){l2[0], l2[1], l2[2], l2[3], h2[0], h2[1], h2[2], h2[3]}, o[d0], 0, 0, 0);   \
        o[d0] = __builtin_amdgcn_mfma_f32_32x32x16_bf16(pa3, (bf16x8){l3[0], l3[1], l3[2], l3[3], h3[0], h3[1], h3[2], h3[3]}, o[d0], 0, 0, 0); } while (0)
    PV_D0(0); PV_D0(1); PV_D0(2); PV_D0(3);
#undef PV_D0
#undef TRRD
}
struct BlockRef { const bf16* Q; const bf16* K; const bf16* V; bf16* O; const float* lf; int P0; };
struct Seam { bf16x8 qr[8]; bf16x8 st_v0, st_v1, st_k0, st_k1; };
#define ROW(p, k0, rr) ((p) + (size_t)((k0) + (rr)) * PITCH + sc)
#define VMW() asm volatile("s_waitcnt vmcnt(0)" ::: "memory")
#define VMWN(n) asm volatile("s_waitcnt vmcnt(%0)" :: "i"(n) : "memory")
#define SLOAD_H(Kp, Vp, k0) do { const bf16* kq_ = (Kp) + (size_t)(k0) * PITCH; const bf16* vq_ = (Vp) + (size_t)(k0) * PITCH; \
                         S.st_v0 = load8(vq_ + soff); S.st_v1 = load8(vq_ + 32 * PITCH + soff); S.st_k0 = load8(kq_ + soff); S.st_k1 = load8(kq_ + 32 * PITCH + soff); } while (0)
#define SWRITE_HK(bf) do { *(bf16x8*)(K_lds + (bf) * SHM_K + kws) = S.st_k0; *(bf16x8*)(K_lds + (bf) * SHM_K + kws + 32 * 256) = S.st_k1; } while (0)
#define SWRITE_HV(bf) do { *(bf16x8*)(V_lds + (bf) * SHM_V + vst0) = S.st_v0; *(bf16x8*)(V_lds + (bf) * SHM_V + vst1) = S.st_v1; } while (0)
#define SWRITE_H(bf) do { SWRITE_HV(bf); SWRITE_HK(bf); } while (0)
__device__ __forceinline__ void prime(const BlockRef& cur, char* lds, Seam& S) {
    const int tid = opaque_tid(), wid = __builtin_amdgcn_readfirstlane(tid >> 6), lane = tid & 63, r32 = lane & 31, hi = lane >> 5;
    const int sr = tid >> 4, sc = (tid & 15) * 8, kws = KSWZ(sr, sc * 2); char* K_lds = lds + 2 * SHM_V; const unsigned soff = sr * PITCH + sc, qoff = r32 * PITCH + hi * 8;
    { const bf16* qb_ = cur.Q + (size_t)(wid * QBLK) * PITCH;
#pragma unroll
    for (int d0 = 0; d0 < 8; ++d0) S.qr[d0] = load8(qb_ + qoff + d0 * 16); }
    SLOAD_H(cur.K, cur.V, 0); VMW(); SWRITE_HK(0);
    __syncthreads();
}
__device__ __forceinline__ void key_bias(const BlockRef& cur, char* lds, int slot) {
    const int tid = opaque_tid(), wid = __builtin_amdgcn_readfirstlane(tid >> 6), lane = tid & 63;
    FLAS float* kb = (FLAS float*)(lds + LDS_KB) + slot * SEQ; FLAS float* wt = (FLAS float*)(lds + LDS_WT);
    const int n = cur.P0 + QB; const bool act = 4 * tid < n;
    float lf[4];
#pragma unroll
    for (int j = 0; j < 4; ++j) lf[j] = act ? cur.lf[(size_t)(4 * tid + j) * 16] : 0.f;
    lf[1] += lf[0]; lf[2] += lf[1]; lf[3] += lf[2];
    float tot = lf[3];
#pragma unroll
    for (int o = 1; o < 64; o <<= 1) { const float t = __shfl_up(tot, o); if (lane >= o) tot += t; }
    if (lane == 63) wt[wid] = tot;
    __syncthreads();
    float off = tot - lf[3];
#pragma unroll
    for (int w = 0; w < 8; ++w) { const float t = wt[w]; if (w < wid) off += t; }
    if (4 * tid == cur.P0) wt[8] = off + lf[0];
    __syncthreads();
    const float cref = wt[8];
    f32x4 o4; o4[0] = (cref - (off + lf[0])) * INV_SCALE; o4[1] = (cref - (off + lf[1])) * INV_SCALE; o4[2] = (cref - (off + lf[2])) * INV_SCALE; o4[3] = (cref - (off + lf[3])) * INV_SCALE;
    *(FLAS f32x4*)(kb + 4 * tid) = o4;
    __syncthreads();
}
__device__ __forceinline__ void block(const BlockRef& cur, const BlockRef& nxt, char* lds, Seam& S, int slot) {
    const int tid = opaque_tid(), wid = __builtin_amdgcn_readfirstlane(tid >> 6), lane = tid & 63, r32 = lane & 31, hi = lane >> 5;
    constexpr int W = WBIG;
    const int NT = (cur.P0 + QB - 1) / KVBLK + 1;
    const int qlo = cur.P0 + wid * QBLK, qm = qlo + r32 - 4 * hi;
    char* V_lds = lds; char* K_lds = lds + 2 * SHM_V;
    float* ws = (float*)(lds + LDS_WS) + wid * 64; float* li_l = ws, * al_l = ws + 32;
    const FLAS float* kbl = (const FLAS float*)(lds + LDS_KB) + slot * SEQ + 4 * hi;
    float m_reg = -1e30f, l_reg = 0; f32x16 o[4] = {};
    const int sr = tid >> 4, sc = (tid & 15) * 8, vst0 = v_st(sr, sc), vst1 = v_st(32 + sr, sc), kws = KSWZ(sr, sc * 2); const unsigned soff = sr * PITCH + sc, qoff = r32 * PITCH + hi * 8;
    const int vb0 = (int)(uintptr_t)V_lds + v_rd_base(lane);
    const bf16* Kh = cur.K; const bf16* Vh = cur.V;
#define RESC(a) do { if (__any((a) < 1.f)) { if (hi == 0) al_l[r32] = (a); asm volatile("s_waitcnt lgkmcnt(0)" ::: "memory");              \
                     for (int d_ = 0; d_ < 4; ++d_) for (int r = 0; r < 16; ++r) o[d_][r] *= al_l[crow(r, hi)]; } } while (0)
#define KBASE(t) ((t) * KVBLK)
#define MASKT(P0_, P1_, t) do { const int kb_ = KBASE(t); if (kb_ + KVBLK - 1 > qlo) mask_tile(P0_, P1_, qm - kb_, (unsigned)W); } while (0)
#define SEAM_K0() do { VMWN(8); SWRITE_HK(0); SBAR(); } while (0)
    f32x16 pA0, pA1, pB0, pB1; float mnA, mnB, alA, alB; bf16x8 pa0, pa1, pa2, pa3;
    SWRITE_HV(0); SBAR();
    if (NT > 1) { SLOAD_H(Kh, Vh, KBASE(1)); }
    SBAR(); qkt<0>(pA0, pA1, K_lds, r32, hi, S.qr, kbl + KBASE(0));
    MASKT(pA0, pA1, 0); partialSM(pA0, pA1, m_reg, mnA, alA);
    if (NT > 1) { VMW(); SWRITE_H(1); }
    __syncthreads();
#define HALF_STEP(PX0, PX1, mnX, alX, PY0, PY1, alY, t, KB, VB, SB) do {                                                      \
        SBAR(); qkt<KB>(PX0, PX1, K_lds, r32, hi, S.qr, kbl + KBASE(t));                                                          \
        finishSM(PY0, PY1, alY, l_reg, pa0, pa1, pa2, pa3); SBAR();                                                           \
        if ((t) + 1 < NT) { SLOAD_H(Kh, Vh, KBASE((t) + 1)); SBAR(); }                                               \
        pv_tile<VB>(o, vb0, pa0, pa1, pa2, pa3); MASKT(PX0, PX1, (t)); partialSM(PX0, PX1, m_reg, mnX, alX);   \
        __syncthreads();                                                                                                      \
        if ((t) + 1 < NT) { VMW(); SWRITE_H(SB); }                                                                          \
        RESC(alX); __syncthreads(); } while (0)
    for (int t = 1; t + 1 < NT; t += 2) {
        HALF_STEP(pB0, pB1, mnB, alB, pA0, pA1, alA, t, 1, 0, 0);
        HALF_STEP(pA0, pA1, mnA, alA, pB0, pB1, alB, t + 1, 0, 1, 1);
    }
    const bool even = (NT & 1) == 0;
    if (even) { SBAR(); qkt<1>(pB0, pB1, K_lds, r32, hi, S.qr, kbl + KBASE(NT - 1)); SBAR(); }
    SLOAD_H(nxt.K, nxt.V, 0); SBAR();
    { const bf16* qb_ = nxt.Q + (size_t)(wid * QBLK) * PITCH;
#pragma unroll
    for (int d0 = 0; d0 < 8; ++d0) S.qr[d0] = load8(qb_ + qoff + d0 * 16); }
    SBAR();
    finishSM(pA0, pA1, alA, l_reg, pa0, pa1, pa2, pa3); SBAR();
    pv_tile<0>(o, vb0, pa0, pa1, pa2, pa3);
    if (even) { MASKT(pB0, pB1, NT - 1); partialSM(pB0, pB1, m_reg, mnB, alB); __syncthreads(); RESC(alB);
        finishSM(pB0, pB1, alB, l_reg, pa0, pa1, pa2, pa3); SBAR(); pv_tile<1>(o, vb0, pa0, pa1, pa2, pa3); }
    SBAR(); SEAM_K0();
    if (hi == 0) li_l[r32] = l_reg; asm volatile("s_waitcnt lgkmcnt(0)" ::: "memory");
    float rli[16];
#pragma unroll
    for (int r = 0; r < 16; ++r) rli[r] = __builtin_amdgcn_rcpf(li_l[crow(r, hi)]);
    bf16* Ow = cur.O + (size_t)(wid * QBLK) * PITCH; const unsigned ooff = 4 * hi * PITCH + r32;
#pragma unroll
    for (int r = 0; r < 16; ++r) { const int orow = crow(r, hi);
#pragma unroll
        for (int d0 = 0; d0 < 4; ++d0) { const float v = o[d0][r] * rli[r];
            const float vn = __shfl_xor(v, 1);
            if ((r32 & 1) == 0) *(unsigned*)(Ow + ((r & 3) + 8 * (r >> 2)) * PITCH + d0 * 32 + ooff) = cvtpk(v, vn); } }
    __syncthreads();
#undef RESC
#undef KBASE
#undef MASKT
#undef SEAM_K0
#undef HALF_STEP
}
#undef ROW
#undef VMW
#undef VMWN
#undef SLOAD_H
#undef SWRITE_HK
#undef SWRITE_HV
#undef SWRITE_H
}
namespace swa {
typedef unsigned short bf16;
typedef short bf16x8 __attribute__((ext_vector_type(8)));
typedef short s16x4 __attribute__((ext_vector_type(4)));
typedef float f32x16 __attribute__((ext_vector_type(16)));
typedef float f32x4 __attribute__((ext_vector_type(4)));
typedef unsigned u32x4 __attribute__((ext_vector_type(4)));
#define SLAS __attribute__((address_space(3)))
using fox::cvtpk;
constexpr int QKVP = 2560, OP = 2048, KROW = 144;
constexpr int LDS_K = 0, LDS_V = 256 * KROW, LDS_WS = LDS_V + 256 * 64 * 2, LDS_BYTES = LDS_WS + 8 * 256;
__device__ __forceinline__ int v_st2(int k, int c) { const int kk = (k & ~0xC) | ((k & 4) << 1) | ((k & 8) >> 1); return ((kk >> 3) * 2 + (c >> 5)) * 512 + ((kk & 7) * 32 + (c & 31)) * 2; }
__device__ __forceinline__ float bf_lo(unsigned w) { return __uint_as_float(w << 16); }
__device__ __forceinline__ float bf_hi(unsigned w) { return __uint_as_float(w & 0xffff0000u); }
__device__ __forceinline__ u32x4 rope8(u32x4 own, u32x4 oth, const float* tab, bool second) {
    const f32x4 c0 = *(const f32x4*)(tab), c1 = *(const f32x4*)(tab + 4), s0 = *(const f32x4*)(tab + 8), s1 = *(const f32x4*)(tab + 12);
    const float sg = second ? 1.f : -1.f;
    float cs[8] = {c0[0], c0[1], c0[2], c0[3], c1[0], c1[1], c1[2], c1[3]}, sn[8] = {s0[0], s0[1], s0[2], s0[3], s1[0], s1[1], s1[2], s1[3]};
    u32x4 r;
#pragma unroll
    for (int i = 0; i < 4; ++i) { const float a0 = bf_lo(own[i]), a1 = bf_hi(own[i]), b0 = bf_lo(oth[i]), b1 = bf_hi(oth[i]);
        const float o0 = a0 * cs[2 * i] + sg * b0 * sn[2 * i], o1 = a1 * cs[2 * i + 1] + sg * b1 * sn[2 * i + 1];
        r[i] = fox::cvtpk(o0, o1); }
    return r;
}
__device__ __forceinline__ void unit(int b, int n, int hk, const bf16* QKV, bf16* O, const float* rope, const float* sinks, char* lds) {
    const int tid = opaque_tid(), wid = __builtin_amdgcn_readfirstlane(tid >> 6), lane = tid & 63, r32 = lane & 31, hi = lane >> 5;
    const bf16* base = QKV + (size_t)(b * 2048) * QKVP;
    SLAS char* l3 = (SLAS char*)lds;
#pragma unroll
    for (int i = 0; i < 4; ++i) { const int row = i * 64 + (tid >> 3), c = tid & 7, s = 128 * (n - 1) + row; const bool valid = s >= 0;
        u32x4 kv = {0u, 0u, 0u, 0u}, vv = {0u, 0u, 0u, 0u};
        if (valid) { kv = *(const u32x4*)(base + (size_t)s * QKVP + 2048 + hk * 64 + 8 * c); vv = *(const u32x4*)(base + (size_t)s * QKVP + 2304 + hk * 64 + 8 * c); }
        u32x4 ot; ot[0] = __shfl_xor(kv[0], 1); ot[1] = __shfl_xor(kv[1], 1); ot[2] = __shfl_xor(kv[2], 1); ot[3] = __shfl_xor(kv[3], 1);
        if (c < 2 && valid) kv = rope8(kv, ot, rope + (size_t)(b * 2048 + s) * 16, c == 1);
        *(SLAS u32x4*)(l3 + LDS_K + row * KROW + c * 16) = kv;
        *(SLAS u32x4*)(l3 + LDS_V + v_st2(row, 8 * c)) = vv; }
    __syncthreads();
    const int hq = hk * 8 + wid;
    const float sinkL = sinks[hq] * 1.4426950408889634f;
    constexpr float C2 = 0.125f * 1.4426950408889634f;
    const int vb0 = LDS_V + fox::v_rd_base(lane);
    SLAS float* li_l = (SLAS float*)(l3 + LDS_WS + wid * 256);
    for (int c4 = 0; c4 < 4; ++c4) {
        const int qrow = b * 2048 + 128 * n + 32 * c4 + r32;
        bf16x8 qr[4];
#pragma unroll
        for (int ks = 0; ks < 4; ++ks) qr[ks] = *(const bf16x8*)(base + (size_t)(128 * n + 32 * c4 + r32) * QKVP + hq * 64 + 16 * ks + 8 * hi);
        { u32x4 own = __builtin_bit_cast(u32x4, qr[0]); u32x4 ot; ot[0] = __shfl_xor(own[0], 32); ot[1] = __shfl_xor(own[1], 32); ot[2] = __shfl_xor(own[2], 32); ot[3] = __shfl_xor(own[3], 32);
          own = rope8(own, ot, rope + (size_t)qrow * 16, hi == 1); qr[0] = __builtin_bit_cast(bf16x8, own); }
        f32x16 p[5];
#pragma unroll
        for (int jb = 0; jb < 5; ++jb) { p[jb] = f32x16{};
            const SLAS char* kp = l3 + LDS_K + (32 * c4 + 32 * jb + r32) * KROW + hi * 16;
#pragma unroll
            for (int ks = 0; ks < 4; ++ks) { const bf16x8 a = *(const SLAS bf16x8*)(kp + ks * 32); p[jb] = __builtin_amdgcn_mfma_f32_32x32x16_bf16(a, qr[ks], p[jb], 0, 0, 0); } }
        float mx = sinkL;
#pragma unroll
        for (int jb = 0; jb < 5; ++jb) { const bool dead = (n == 0) && (c4 + jb < 4);
#pragma unroll
            for (int r = 0; r < 16; ++r) { const int rel = r32 + 128 - 32 * jb - fox::crow(r, hi); const bool ok = ((unsigned)rel < 128u) && !dead;
                const float t = ok ? p[jb][r] * C2 : -__builtin_inff(); p[jb][r] = t; mx = fmaxf(mx, t); } }
        { auto rr = __builtin_amdgcn_permlane32_swap(__float_as_uint(mx), __float_as_uint(mx), false, false); mx = fmaxf(__uint_as_float(rr[0]), __uint_as_float(rr[1])); }
        float ps = 0.f;
#pragma unroll
        for (int jb = 0; jb < 5; ++jb)
#pragma unroll
            for (int r = 0; r < 16; ++r) { const float e = __builtin_amdgcn_exp2f(p[jb][r] - mx); p[jb][r] = e; ps += e; }
        { auto rr = __builtin_amdgcn_permlane32_swap(__float_as_uint(ps), __float_as_uint(ps), false, false); ps = __uint_as_float(rr[0]) + __uint_as_float(rr[1]); }
        ps += __builtin_amdgcn_exp2f(sinkL - mx);
        f32x16 o[2]; o[0] = f32x16{}; o[1] = f32x16{};
#pragma unroll
        for (int jb = 0; jb < 5; ++jb) { bf16x8 pa0, pa1; PK4(p[jb], 0, pa0); PK4(p[jb], 8, pa1);
            const SLAS char* vp = l3 + vb0 + (2 * c4 + 2 * jb) * 2048;
#pragma unroll
            for (int d0 = 0; d0 < 2; ++d0) {
                const s16x4 l0 = __builtin_bit_cast(s16x4, __builtin_amdgcn_ds_read_tr16_b64_v4i16((SLAS s16x4*)(vp + d0 * 512)));
                const s16x4 h0 = __builtin_bit_cast(s16x4, __builtin_amdgcn_ds_read_tr16_b64_v4i16((SLAS s16x4*)(vp + d0 * 512 + 1024)));
                const s16x4 l1 = __builtin_bit_cast(s16x4, __builtin_amdgcn_ds_read_tr16_b64_v4i16((SLAS s16x4*)(vp + d0 * 512 + 2048)));
                const s16x4 h1 = __builtin_bit_cast(s16x4, __builtin_amdgcn_ds_read_tr16_b64_v4i16((SLAS s16x4*)(vp + d0 * 512 + 3072)));
                o[d0] = __builtin_amdgcn_mfma_f32_32x32x16_bf16(pa0, (bf16x8){l0[0], l0[1], l0[2], l0[3], h0[0], h0[1], h0[2], h0[3]}, o[d0], 0, 0, 0);
                o[d0] = __builtin_amdgcn_mfma_f32_32x32x16_bf16(pa1, (bf16x8){l1[0], l1[1], l1[2], l1[3], h1[0], h1[1], h1[2], h1[3]}, o[d0], 0, 0, 0); } }
        if (hi == 0) li_l[r32] = ps;
        asm volatile("s_waitcnt lgkmcnt(0)" ::: "memory");
        bf16* Ow = O + (size_t)(b * 2048 + 128 * n + 32 * c4) * OP + hq * 64;
#pragma unroll
        for (int r = 0; r < 16; ++r) { const int orow = fox::crow(r, hi); const float rl = __builtin_amdgcn_rcpf(li_l[orow]);
#pragma unroll
            for (int d0 = 0; d0 < 2; ++d0) { const float v = o[d0][r] * rl; const float vn = __shfl_xor(v, 1);
                if ((r32 & 1) == 0) *(unsigned*)(Ow + (size_t)orow * OP + d0 * 32 + r32) = fox::cvtpk(v, vn); } }
        asm volatile("s_waitcnt lgkmcnt(0)" ::: "memory");
    }
    __syncthreads();
}
}
#define LAS __attribute__((address_space(3)))
typedef unsigned short bf16_t;
typedef float f32x4 __attribute__((ext_vector_type(4)));
typedef unsigned u32x4 __attribute__((ext_vector_type(4)));
typedef unsigned u32x2 __attribute__((ext_vector_type(2)));
typedef short bf16x8 __attribute__((ext_vector_type(8)));
constexpr int M = 16384, DM = 2048, SEQ = 2048, NB = 8, DFF = 5632, NFIN = 6160, NSIN = 2560;
constexpr float LN_EPS = 1e-5f, ALPHA = 1.4142135623730951f;
constexpr size_t MiB = 1u << 20;
constexpr size_t WS_MOD = 1 * MiB;
constexpr size_t WS_ROPE = 2 * MiB;
constexpr size_t WS_LOGF = 3 * MiB;
constexpr size_t WS_UBUF = 4 * MiB;
constexpr size_t WS_WFIN = 16 * MiB;
constexpr size_t WS_WFO = 42 * MiB;
constexpr size_t WS_WSIN = 50 * MiB;
constexpr size_t WS_WSO = 60 * MiB;
constexpr size_t WS_WUP = 68 * MiB;
constexpr size_t WS_WDN = 156 * MiB;
constexpr size_t WS_H = 200 * MiB;
constexpr size_t WS_Z = 264 * MiB;
constexpr size_t WS_Q = 392 * MiB;
constexpr size_t WS_K = 456 * MiB, WS_V = 520 * MiB;
constexpr size_t WS_O = 584 * MiB;
constexpr size_t WS_END = 648 * MiB;
constexpr int LDS_HALO = 131072, LDS_PTAB = 139264, LDS_BYTES = 147456;

__device__ __forceinline__ unsigned pk2(float lo, float hi) { return pg8::cvt_pk_bf16(lo, hi); }
__device__ __forceinline__ float wave_sum(float v) {
#pragma unroll
    for (int o = 1; o < 64; o <<= 1) v += __shfl_xor(v, o);
    return v;
}
__device__ __forceinline__ int perm_up(int n) { const int half = n >= DFF ? 1 : 0, ch = n - half * DFF; return (ch >> 7) * 256 + half * 128 + (ch & 127); }
template <int MODE> __device__ __forceinline__ void tr_item(const float* W, int K, int N, bf16_t* WT, LAS float* scr, int item, int lane) {
    const int nblk = (N + 31) / 32, kb = item / nblk, nb = item % nblk, k0 = 64 * kb, n0 = 32 * nb;
    const int nn = n0 + (lane & 31); const bool ok = nn < N;
#pragma unroll 8
    for (int i = 0; i < 32; ++i) { const int kk = 2 * i + (lane >> 5); scr[kk * 33 + (lane & 31)] = ok ? W[(size_t)(k0 + kk) * N + nn] : 0.f; }
    asm volatile("s_waitcnt lgkmcnt(0)" ::: "memory");
    const int c = lane & 7;
#pragma unroll
    for (int j = 0; j < 4; ++j) { const int n = (lane >> 3) + 8 * j; const LAS float* s = scr + (8 * c) * 33 + n;
        u32x4 o; o.x = pk2(s[0 * 33], s[1 * 33]); o.y = pk2(s[2 * 33], s[3 * 33]); o.z = pk2(s[4 * 33], s[5 * 33]); o.w = pk2(s[6 * 33], s[7 * 33]);
        const int ng = n0 + n; if (ng < N) { const int dr = MODE == 1 ? perm_up(ng) : ng; *(u32x4*)(WT + (size_t)dr * K + k0 + 8 * c) = o; } }
    asm volatile("s_waitcnt lgkmcnt(0)" ::: "memory");
}
__device__ __forceinline__ float log_sigmoid(float x) { return fminf(x, 0.f) - log1pf(expf(-fabsf(x))); }

#ifndef PH
#define PH 0xFFFF
#endif
#define ON(k) ((PH >> (k)) & 1)
struct Args { const void* in[19]; float* out; unsigned char* ws; };
__device__ __forceinline__ const void* ldp(LAS unsigned long long* ptab, int i) { const unsigned long long v = ptab[i];
    const unsigned lo = __builtin_amdgcn_readfirstlane((unsigned)v), hi = __builtin_amdgcn_readfirstlane((unsigned)(v >> 32)); return (const void*)(const __attribute__((address_space(1))) void*)(((unsigned long long)hi << 32) | lo); }

__global__ void __launch_bounds__(512, 2) fwd_kernel(Args a) {
    extern __shared__ __attribute__((aligned(16))) unsigned char lds[];
    cg::grid_group grid = cg::this_grid();
#define tid (opaque_tid())
#define lane (opaque_tid() & 63)
#define wid (__builtin_amdgcn_readfirstlane(opaque_tid() >> 6))
    constexpr int G = 256, NGW = G * 8;
#define bid ((int)blockIdx.x)
#define vcu ((bid % 8) * (G / 8) + bid / 8)
#define gw (bid * 8 + wid)
    LAS unsigned long long* ptab = (LAS unsigned long long*)(lds + LDS_PTAB);
    if (tid < 19) ptab[tid] = (unsigned long long)a.in[tid];
    if (tid == 19) ptab[19] = (unsigned long long)a.out;
    if (tid == 20) ptab[20] = (unsigned long long)a.ws;
    __syncthreads();
#define LDP(i) ldp(ptab, (i))
#define x_in ((const float*)LDP(0))
#define c_in ((const float*)LDP(1))
#define pos_in ((const int*)LDP(2))
#define fox_w_in ((const float*)LDP(3))
#define fox_b_f ((const float*)LDP(4))
#define fox_w_o ((const float*)LDP(5))
#define swa_w_in ((const float*)LDP(6))
#define swa_sinks ((const float*)LDP(7))
#define swa_w_o ((const float*)LDP(8))
#define ada_w ((const float*)LDP(9))
#define ada_b ((const float*)LDP(10))
#define ffn_w_up ((const float*)LDP(11))
#define ffn_conv_w ((const float*)LDP(12))
#define ffn_conv_b ((const float*)LDP(13))
#define ffn_w_down ((const float*)LDP(14))
#define ln_mix_g ((const float*)LDP(15))
#define ln_mix_b ((const float*)LDP(16))
#define ln_ffn_g ((const float*)LDP(17))
#define ln_ffn_b ((const float*)LDP(18))
#define xcur ((float*)LDP(19))
#define WSP ((unsigned char*)LDP(20))
#define mod ((float*)(WSP + WS_MOD))
#define rope ((float*)(WSP + WS_ROPE))
#define logf_ ((float*)(WSP + WS_LOGF))
#define ubuf ((float*)(WSP + WS_UBUF))
#define Wfin ((bf16_t*)(WSP + WS_WFIN))
#define Wfo ((bf16_t*)(WSP + WS_WFO))
#define Wsin ((bf16_t*)(WSP + WS_WSIN))
#define Wso ((bf16_t*)(WSP + WS_WSO))
#define Wup ((bf16_t*)(WSP + WS_WUP))
#define Wdn ((bf16_t*)(WSP + WS_WDN))
#define Hb ((bf16_t*)(WSP + WS_H))
#define Zb ((float*)(WSP + WS_Z))
#define Qb ((bf16_t*)(WSP + WS_Q))
#define Kb ((bf16_t*)(WSP + WS_K))
#define Vb ((bf16_t*)(WSP + WS_V))
#define Ob ((bf16_t*)(WSP + WS_O))
#define Actb Qb

    if (ON(0)) {
        const int i = bid * 512 + tid;
        float* rope_ = rope; const int* pos_ = pos_in;
        if (i < M * 8) { const int m = i >> 3, f = i & 7; const float inv = (float)pow(500000.0, -(double)f / 8.0); const float ang = (float)pos_[m] * inv;
            rope_[m * 16 + f] = (float)cos((double)ang); rope_[m * 16 + 8 + f] = (float)sin((double)ang); }
    }
    if (ON(1) && bid < 192) {
        LAS float* sc = (LAS float*)lds; LAS float* red = (LAS float*)(lds + 65536);
        const float* cin_ = c_in; const float* adaw_ = ada_w; const float* adab_ = ada_b; float* mod_ = mod;
        for (int i = tid; i < NB * DM; i += 512) { const int b = i >> 11, k = i & 2047; const float v = cin_[i]; sc[k * 8 + b] = v / (1.f + expf(-v)); }
        __syncthreads();
        const int l = bid / 96, n0 = (bid % 96) * 128, kq = tid >> 5, cl = tid & 31;
        const float* W = adaw_ + (size_t)l * DM * 12288 + n0 + 4 * cl;
        f32x4 acc[8];
#pragma unroll
        for (int b = 0; b < 8; ++b) acc[b] = (f32x4){0.f, 0.f, 0.f, 0.f};
#pragma unroll 4
        for (int kk = 0; kk < 128; ++kk) { const int k = kq + 16 * kk; const f32x4 w = *(const f32x4*)(W + (size_t)k * 12288);
            const f32x4 s0 = *(const LAS f32x4*)(sc + k * 8), s1 = *(const LAS f32x4*)(sc + k * 8 + 4);
            acc[0] += w * s0[0]; acc[1] += w * s0[1]; acc[2] += w * s0[2]; acc[3] += w * s0[3]; acc[4] += w * s1[0]; acc[5] += w * s1[1]; acc[6] += w * s1[2]; acc[7] += w * s1[3]; }
#pragma unroll
        for (int b = 0; b < 8; ++b) *(LAS f32x4*)(red + (kq * 8 + b) * 128 + 4 * cl) = acc[b];
        __syncthreads();
        for (int o = tid; o < 1024; o += 512) { const int b = o >> 7, col = o & 127; float s = 0.f;
#pragma unroll
            for (int q = 0; q < 16; ++q) s += red[(q * 8 + b) * 128 + col];
            mod_[(size_t)(l * 8 + b) * 12288 + n0 + col] = s + adab_[l * 12288 + n0 + col]; }
        __syncthreads();
    }
    if (ON(2)) {
        LAS float* scr = (LAS float*)(lds + wid * 16384);
        const float* p_fin = fox_w_in; const float* p_fo = fox_w_o; const float* p_sin = swa_w_in; const float* p_so = swa_w_o; const float* p_up = ffn_w_up; const float* p_dn = ffn_w_down; unsigned char* wsl = WSP;
        constexpr int I_FIN = 32 * 193, I_SQ = 32 * 64, I_SIN = 32 * 80, I_UP = 32 * 352, I_DN = 88 * 64;
        constexpr int NITEMS = I_FIN + 2 * I_SQ + I_SIN + 2 * I_UP + 2 * I_DN;
        for (int it = gw; it < NITEMS; it += NGW) {
            int r = it;
            if (r < I_FIN) { tr_item<0>(p_fin, DM, NFIN, (bf16_t*)(wsl + WS_WFIN), scr, r, lane); continue; } r -= I_FIN;
            if (r < I_SQ) { tr_item<0>(p_fo, DM, DM, (bf16_t*)(wsl + WS_WFO), scr, r, lane); continue; } r -= I_SQ;
            if (r < I_SIN) { tr_item<0>(p_sin, DM, NSIN, (bf16_t*)(wsl + WS_WSIN), scr, r, lane); continue; } r -= I_SIN;
            if (r < I_SQ) { tr_item<0>(p_so, DM, DM, (bf16_t*)(wsl + WS_WSO), scr, r, lane); continue; } r -= I_SQ;
            if (r < 2 * I_UP) { const int l = r / I_UP; tr_item<1>(p_up + (size_t)l * DM * 2 * DFF, DM, 2 * DFF, (bf16_t*)(wsl + WS_WUP) + (size_t)l * 2 * DFF * DM, scr, r - l * I_UP, lane); continue; } r -= 2 * I_UP;
            { const int l = r / I_DN; tr_item<0>(p_dn + (size_t)l * DFF * DM, DFF, DM, (bf16_t*)(wsl + WS_WDN) + (size_t)l * DM * DFF, scr, r - l * I_DN, lane); }
        }
    }
    grid.sync();

    for (int l = 0; l < 2; ++l) {
#define modl (mod + (size_t)l * 8 * 12288)
        if (ON(3) && l == 0) {
            const float* xin_ = x_in; const float* mod0_ = modl; bf16_t* hb_ = Hb;
            for (int m = gw; m < M; m += NGW) { const float* sh = mod0_ + (size_t)(m >> 11) * 12288; const float* scv = sh + 2048;
                const f32x4* xr = (const f32x4*)(xin_ + (size_t)m * DM) + lane; u32x2* ho = (u32x2*)(hb_ + (size_t)m * DM) + lane;
#pragma unroll
                for (int j = 0; j < 8; ++j) { const f32x4 v = xr[64 * j], s = *((const f32x4*)scv + lane + 64 * j), t = *((const f32x4*)sh + lane + 64 * j);
                    const f32x4 h = v * (s + 1.0f) + t; u32x2 w; w.x = pk2(h[0], h[1]); w.y = pk2(h[2], h[3]); ho[64 * j] = w; } }
            grid.sync();
        }
        if (l == 0) {
            if (ON(4) && wid < 4) { const int m0 = (bid * 4 + wid) * 16; const bf16_t* hb_ = Hb; const bf16_t* wf_ = Wfin; const float* bfp_ = fox_b_f; float* lfo_ = logf_;
                if (m0 < M) { const bf16_t* ap = hb_ + (size_t)(m0 + (lane & 15)) * DM + 8 * (lane >> 4); const bf16_t* bp = wf_ + (size_t)(6144 + (lane & 15)) * DM + 8 * (lane >> 4);
                    f32x4 c0 = {0.f, 0.f, 0.f, 0.f}, c1 = c0, c2 = c0, c3 = c0;
#pragma unroll 2
                    for (int kk = 0; kk < 64; kk += 4) {
                        c0 = __builtin_amdgcn_mfma_f32_16x16x32_bf16(*(const bf16x8*)(ap + kk * 32), *(const bf16x8*)(bp + kk * 32), c0, 0, 0, 0);
                        c1 = __builtin_amdgcn_mfma_f32_16x16x32_bf16(*(const bf16x8*)(ap + kk * 32 + 32), *(const bf16x8*)(bp + kk * 32 + 32), c1, 0, 0, 0);
                        c2 = __builtin_amdgcn_mfma_f32_16x16x32_bf16(*(const bf16x8*)(ap + kk * 32 + 64), *(const bf16x8*)(bp + kk * 32 + 64), c2, 0, 0, 0);
                        c3 = __builtin_amdgcn_mfma_f32_16x16x32_bf16(*(const bf16x8*)(ap + kk * 32 + 96), *(const bf16x8*)(bp + kk * 32 + 96), c3, 0, 0, 0); }
                    const f32x4 cs = (c0 + c1) + (c2 + c3); const float bf = bfp_[lane & 15];
#pragma unroll
                    for (int r = 0; r < 4; ++r) lfo_[(size_t)(m0 + (lane >> 4) * 4 + r) * 16 + (lane & 15)] = log_sigmoid(cs[r] + bf); } }
            if (ON(5)) { pg8::Gemm g{Hb, Wfin, M, 6144, DM}; pg8::StaticOrder S; S.init(M, 6144, G, bid);
              pg8::EpiBf16 E{Qb, DM, DM, (size_t)(WS_K - WS_Q) / 2};
              pg8::gemm_phase<pg8::EpiBf16, pg8::StaticOrder, true, true>((LAS unsigned char*)lds, g, S, E); }
            grid.sync();
            if (ON(6)) {
                fox::Seam S;
                auto mk = [](int j, int vcu_, const bf16_t* Q, const bf16_t* K, const bf16_t* V, bf16_t* O, const float* lf) {
                    const int item = vcu_ + 256 * (j >> 1), bh = item >> 2, xq = item & 3, qb = (j & 1) ? 7 - xq : xq, b = bh >> 4, h = bh & 15;
                    fox::BlockRef r; const size_t ro = (size_t)(b * SEQ) * DM + h * 128;
                    r.Q = Q + ro + (size_t)(qb * 256) * DM; r.K = K + ro; r.V = V + ro; r.O = O + ro + (size_t)(qb * 256) * DM; r.lf = lf + (size_t)(b * SEQ) * 16 + h; r.P0 = qb * 256; return r; };
                { const float* lfp_ = logf_;
                  for (int j = 0; j < 4; ++j) { const fox::BlockRef r = mk(j, vcu, nullptr, nullptr, nullptr, nullptr, lfp_); fox::key_bias(r, (char*)lds, j); } }
                int vc2 = vcu; asm volatile("" : "+s"(vc2));
                const bf16_t* q_ = Qb; const bf16_t* k_ = Kb; const bf16_t* v_ = Vb; bf16_t* o_ = Ob;
                fox::BlockRef cur = mk(0, vc2, q_, k_, v_, o_, nullptr);
                fox::prime(cur, (char*)lds, S);
                for (int j = 0; j < 4; ++j) { const fox::BlockRef nxt = (j < 3) ? mk(j + 1, vc2, q_, k_, v_, o_, nullptr) : cur;
                    fox::block(cur, nxt, (char*)lds, S, j); cur = nxt; }
            }
            grid.sync();
        } else {
            if (ON(7)) { pg8::Gemm g{Hb, Wsin, M, NSIN, DM}; pg8::StaticOrder S; S.init(M, NSIN, G, bid);
              pg8::EpiBf16 E{Qb, NSIN, 0, 0};
              pg8::gemm_phase<pg8::EpiBf16, pg8::StaticOrder, true, true>((LAS unsigned char*)lds, g, S, E); }
            grid.sync();
            if (ON(8)) { const bf16_t* qkv_ = Qb; bf16_t* o_ = Ob; const float* rp_ = rope; const float* sk_ = swa_sinks;
              for (int u = vcu; u < 512; u += G) { const int hk = u & 3, n = (u >> 2) & 15, b = u >> 6; swa::unit(b, n, hk, qkv_, o_, rp_, sk_, (char*)lds); } }
            grid.sync();
        }
        if (ON(9)) { pg8::Gemm g{Ob, l == 0 ? Wfo : Wso, M, DM, DM}; pg8::StaticOrder S; S.init(M, DM, G, bid);
          pg8::EpiZ E{l == 0 ? x_in : xcur, Zb, modl + 2 * 2048, ALPHA};
          pg8::gemm_phase<pg8::EpiZ, pg8::StaticOrder, true, true>((LAS unsigned char*)lds, g, S, E); }
        grid.sync();
#define LN_PHASE(GV, BV, SHV, SCV, WRITE_H) do { const float* zb_ = Zb; float* xc_ = xcur; bf16_t* hb_ = Hb; const float* gv_ = (GV); const float* bv_ = (BV); const float* shv_ = (SHV); const float* scv_ = (SCV); \
        for (int m = gw; m < M; m += NGW) { const f32x4* zr = (const f32x4*)(zb_ + (size_t)m * DM) + lane; f32x4 v[8]; float s = 0.f; \
            _Pragma("unroll") for (int j = 0; j < 8; ++j) { v[j] = zr[64 * j]; s += (v[j][0] + v[j][1]) + (v[j][2] + v[j][3]); } \
            const float mean = wave_sum(s) * (1.f / DM); float s2 = 0.f; \
            _Pragma("unroll") for (int j = 0; j < 8; ++j) { v[j] = v[j] - mean; s2 += (v[j][0] * v[j][0] + v[j][1] * v[j][1]) + (v[j][2] * v[j][2] + v[j][3] * v[j][3]); } \
            const float rstd = 1.f / sqrtf(wave_sum(s2) * (1.f / DM) + LN_EPS); \
            f32x4* xo = (f32x4*)(xc_ + (size_t)m * DM) + lane; u32x2* ho = (u32x2*)(hb_ + (size_t)m * DM) + lane; \
            const float* shp = shv_ + (size_t)(m >> 11) * 12288; const float* scp = scv_ + (size_t)(m >> 11) * 12288; \
            _Pragma("unroll") for (int j = 0; j < 8; ++j) { const f32x4 gg = *((const f32x4*)gv_ + lane + 64 * j), bb = *((const f32x4*)bv_ + lane + 64 * j); \
                const f32x4 y = v[j] * rstd * gg + bb; xo[64 * j] = y; \
                if (WRITE_H) { const f32x4 sv = *((const f32x4*)scp + lane + 64 * j), tv = *((const f32x4*)shp + lane + 64 * j); const f32x4 h = y * (sv + 1.0f) + tv; \
                    u32x2 w; w.x = pk2(h[0], h[1]); w.y = pk2(h[2], h[3]); ho[64 * j] = w; } } } } while (0)
        if (ON(10)) LN_PHASE(ln_mix_g + l * DM, ln_mix_b + l * DM, modl + 3 * 2048, modl + 4 * 2048, true);
        grid.sync();
        if (ON(11)) { pg8::Gemm g{Hb, Wup + (size_t)l * 2 * DFF * DM, M, 2 * DFF, DM}; pg8::StaticOrder S; S.init(M, 2 * DFF, G, bid);
          pg8::EpiUp E{Actb, ubuf, ffn_conv_w + (size_t)l * 3 * 2 * DFF, ffn_conv_b + (size_t)l * 2 * DFF, (LAS unsigned char*)lds + LDS_HALO};
          pg8::gemm_phase<pg8::EpiUp, pg8::StaticOrder, true, true>((LAS unsigned char*)lds, g, S, E); }
        grid.sync();
        if (ON(12)) {
            const float* cw = ffn_conv_w + (size_t)l * 3 * 2 * DFF; const float* cb = ffn_conv_b + (size_t)l * 2 * DFF; const float* ub_ = ubuf; bf16_t* act_ = Actb;
            for (int i = bid * 512 + tid; i < 64 * 2 * (DFF / 4); i += G * 512) { const int pm = i / (2 * (DFF / 4)), rem = i % (2 * (DFF / 4)), r = rem / (DFF / 4), c4 = (rem % (DFF / 4)) * 4;
                if ((pm & 7) == 0) continue;
                f32x4 y[2];
#pragma unroll
                for (int hf = 0; hf < 2; ++hf) { const float* up = ub_ + ((size_t)((pm - 1) * 4) * 2 + hf) * DFF + c4; const float* uc = ub_ + ((size_t)(pm * 4) * 2 + hf) * DFF + c4;
                    const f32x4 um2 = *(const f32x4*)(up + (size_t)2 * 2 * DFF), um1 = *(const f32x4*)(up + (size_t)3 * 2 * DFF), u0 = *(const f32x4*)(uc), u1 = *(const f32x4*)(uc + (size_t)2 * DFF);
                    const int ci = hf * DFF + c4; const f32x4 w0 = *(const f32x4*)(cw + ci), w1 = *(const f32x4*)(cw + 2 * DFF + ci), w2 = *(const f32x4*)(cw + 4 * DFF + ci), b4 = *(const f32x4*)(cb + ci);
                    y[hf] = (r == 0) ? (w0 * um2 + w1 * um1 + w2 * u0 + b4) : (w0 * um1 + w1 * u0 + w2 * u1 + b4); }
                float o[4];
#pragma unroll
                for (int e = 0; e < 4; ++e) { const float gq = y[0][e]; o[e] = gq / (1.f + expf(-gq)) * y[1][e]; }
                u32x2 w; w.x = pk2(o[0], o[1]); w.y = pk2(o[2], o[3]); *(u32x2*)(act_ + (size_t)(pm * 256 + r) * DFF + c4) = w; }
        }
        grid.sync();
        if (ON(13)) { pg8::Gemm g{Actb, Wdn + (size_t)l * DM * DFF, M, DM, DFF}; pg8::StaticOrder S; S.init(M, DM, G, bid);
          pg8::EpiZ E{xcur, Zb, modl + 5 * 2048, ALPHA};
          pg8::gemm_phase<pg8::EpiZ, pg8::StaticOrder, true, true>((LAS unsigned char*)lds, g, S, E); }
        grid.sync();
        if (!ON(14)) {} else if (l == 0) { LN_PHASE(ln_ffn_g, ln_ffn_b, mod + (size_t)8 * 12288, mod + (size_t)8 * 12288 + 2048, true); grid.sync(); }
        else { LN_PHASE(ln_ffn_g + DM, ln_ffn_b + DM, mod, mod, false); }
    }
}

extern "C" void kernel_launch(void* const* d_in, const int* in_sizes, int n_in, void* d_out, int out_size, void* d_ws, size_t ws_size, hipStream_t stream) {
    static int grid = 0;
    if (grid == 0) {
        if (n_in != 19 || out_size != M * DM || ws_size < WS_END) { fprintf(stderr, "kernel_launch: unexpected shapes (n_in %d out %d ws %zu)\n", n_in, out_size, ws_size); grid = -1; return; }
        int dev = 0, cus = 0, per_cu = 0;
        (void)hipGetDevice(&dev); (void)hipDeviceGetAttribute(&cus, hipDeviceAttributeMultiprocessorCount, dev);
        if (hipFuncSetAttribute((const void*)fwd_kernel, hipFuncAttributeMaxDynamicSharedMemorySize, LDS_BYTES) != hipSuccess) { fprintf(stderr, "kernel_launch: hipFuncSetAttribute failed\n"); grid = -1; return; }
        if (hipOccupancyMaxActiveBlocksPerMultiprocessor(&per_cu, (const void*)fwd_kernel, 512, LDS_BYTES) != hipSuccess || per_cu < 1) { fprintf(stderr, "kernel_launch: occupancy query says %d\n", per_cu); per_cu = 1; }
        (void)hipGetLastError();
        if (cus != 256) fprintf(stderr, "kernel_launch: %d CUs (built for 256)\n", cus);
        grid = 256;
    }
    if (grid < 0) return;
    Args a{};
    for (int i = 0; i < 19; ++i) a.in[i] = d_in[i];
    a.out = (float*)d_out; a.ws = (unsigned char*)d_ws;
    void* params[] = {&a};
    const hipError_t e = hipLaunchCooperativeKernel((const void*)fwd_kernel, dim3(grid), dim3(512), params, LDS_BYTES, stream);
    if (e != hipSuccess) fprintf(stderr, "kernel_launch: cooperative launch failed: %s\n", hipGetErrorString(e));
}
```

```cpp
#include <hip/hip_runtime.h>
#include <hip/hip_cooperative_groups.h>
#include <cstdio>
#include <cstdint>
#include <cmath>
namespace cg = cooperative_groups;
__device__ __forceinline__ int opaque_tid() { int t = threadIdx.x; asm volatile("" : "+v"(t)); return t & 511; }
namespace pg8 {
#define PG8_LAS __attribute__((address_space(3)))
typedef unsigned short bf16_t;
typedef short bf16x8 __attribute__((ext_vector_type(8)));
typedef float f32x4 __attribute__((ext_vector_type(4)));
typedef unsigned u32x4 __attribute__((ext_vector_type(4)));
typedef unsigned u32x2 __attribute__((ext_vector_type(2)));
constexpr int BM = 256, BK = 64, HALF = 128, HTB = HALF * BK * 2  , STAGE_BYTES = 8 * HTB, NXCD = 8, WGM = 8;

__host__ __device__ __forceinline__ int lds_byte(int r, int c) { const int st = (r >> 4) * 2 + (c >> 5), rr = r & 15, cc = c & 31, ob = rr * 64 + cc * 2; return st * 1024 + (ob ^ (((ob >> 9) & 1) << 5)); }
__host__ __device__ __forceinline__ void stage_rc(int b, int& R, int& C) { const int st = b / 1024, sb = b % 1024, swz = sb ^ (((sb >> 9) & 1) << 5); R = (st >> 1) * 16 + swz / 64; C = (st & 1) * 32 + (swz % 64) / 2; }
__host__ __device__ __forceinline__ int perm32(int rho) { const int n = rho >> 4, i = rho & 15; return 8 * (i >> 2) + 4 * n + (i & 3); }

struct Unit { int pm, pn; };
struct Gemm { const bf16_t* A; const bf16_t* Bt; int M, N, K; };

struct StaticOrder {
    int nM, nN, nwg, G, c;
    __host__ __device__ void init(int M, int N, int G_, int c_) { nM = M / BM; nN = N / BM; nwg = nM * nN; G = G_; c = c_; }
    __host__ __device__ bool next(int i, Unit& u) const {
        const long L = (long)i * G + c; if (L >= nwg) return false;
        int wgid = (int)L; { const int q = nwg / NXCD, r = nwg % NXCD, xcd = wgid % NXCD, off = wgid / NXCD; wgid = (xcd < r ? xcd * (q + 1) : r * (q + 1) + (xcd - r) * q) + off; }
        const int nig = WGM * nN, gid = wgid / nig, fm = gid * WGM, gsz = (nM - fm) < WGM ? (nM - fm) : WGM;
        u.pm = fm + ((wgid % nig) % gsz); u.pn = (wgid % nig) / gsz; return true;
    }
    __device__ __forceinline__ void a_ready(const Unit&) const {}
    __device__ __forceinline__ void done(const Unit&) const {}
};

__device__ __forceinline__ unsigned cvt_pk_bf16(float lo, float hi) { unsigned r; asm volatile("v_cvt_pk_bf16_f32 %0, %1, %2" : "=v"(r) : "v"(lo), "v"(hi)); return r; }
struct EpiBf16 {
    static constexpr bool PERM = true, AFTER_DRAIN = false;
    bf16_t* O; int ldc; int split_cols; size_t split_stride;
    __device__ __forceinline__ void operator()(const f32x4 (&acc)[2][2][4][2], const Unit& u, int wr, int wc, int fr, int fq) const {
        const int row0 = u.pm * BM + wr * 64 + fr; int colt = u.pn * BM; bf16_t* base = O;
        if (split_cols) { const int t = colt / split_cols; base += (size_t)t * split_stride; colt -= t * split_cols; }
        const int col0 = colt + wc * 32 + 8 * fq;
#pragma unroll
        for (int ai = 0; ai < 2; ++ai)
#pragma unroll
            for (int m = 0; m < 4; ++m) { bf16_t* rowp = base + (size_t)(row0 + ai * HALF + m * 16) * ldc + col0;
#pragma unroll
                for (int bj = 0; bj < 2; ++bj) { const f32x4 v0 = acc[ai][bj][m][0], v1 = acc[ai][bj][m][1];
                    u32x4 w; w.x = cvt_pk_bf16(v0[0], v0[1]); w.y = cvt_pk_bf16(v0[2], v0[3]); w.z = cvt_pk_bf16(v1[0], v1[1]); w.w = cvt_pk_bf16(v1[2], v1[3]);
                    *(u32x4*)(rowp + bj * HALF) = w; } }
    }
};
struct EpiZ {
    static constexpr bool PERM = false, AFTER_DRAIN = false;
    const float* xres; float* z; const float* gate; float alpha;
    __device__ __forceinline__ void operator()(const f32x4 (&acc)[2][2][4][2], const Unit& u, int wr, int wc, int fr, int fq) const {
        const float* gv = gate + (size_t)(u.pm >> 3) * 12288;
        const int col0 = u.pn * BM + wc * 32 + 4 * fq;
        f32x4 g[2][2];
#pragma unroll
        for (int bj = 0; bj < 2; ++bj)
#pragma unroll
            for (int n = 0; n < 2; ++n) g[bj][n] = *(const f32x4*)(gv + col0 + bj * HALF + n * 16) + 1.0f;
#pragma unroll
        for (int ai = 0; ai < 2; ++ai)
#pragma unroll
            for (int m = 0; m < 4; ++m) { const size_t off = (size_t)(u.pm * BM + ai * HALF + wr * 64 + m * 16 + fr) * 2048 + col0;
#pragma unroll
                for (int bj = 0; bj < 2; ++bj)
#pragma unroll
                    for (int n = 0; n < 2; ++n) { const f32x4 xr = *(const f32x4*)(xres + off + bj * HALF + n * 16);
                        *(f32x4*)(z + off + bj * HALF + n * 16) = xr * alpha + g[bj][n] * acc[ai][bj][m][n]; }
                asm volatile("" ::: "memory"); }
    }
};
__device__ __forceinline__ float dpp_ror1(float v) { return __builtin_bit_cast(float, __builtin_amdgcn_update_dpp(0, __builtin_bit_cast(int, v), 0x121, 0xf, 0xf, false)); }
__device__ __forceinline__ float dpp_ror2(float v) { return __builtin_bit_cast(float, __builtin_amdgcn_update_dpp(0, __builtin_bit_cast(int, v), 0x122, 0xf, 0xf, false)); }
struct EpiUp {
    static constexpr bool PERM = true, AFTER_DRAIN = false;
    bf16_t* act; float* ubuf; const float* cw; const float* cb; PG8_LAS unsigned char* halo;
    __device__ __forceinline__ void operator()(const f32x4 (&acc)[2][2][4][2], const Unit& u, int wr, int wc, int fr, int fq) const {
        const int tcol = wc * 32 + 8 * fq;
        const int ch0 = u.pn * 128 + tcol;
        if (fr >= 14) {
#pragma unroll
            for (int ai = 0; ai < 2; ++ai) { const int blk = 2 * ai + wr;
                if (blk < 3) {
#pragma unroll
                    for (int bj = 0; bj < 2; ++bj)
#pragma unroll
                        for (int n = 0; n < 2; ++n) *(PG8_LAS f32x4*)(halo + (size_t)(((blk * 2 + (fr - 14)) * 256) + bj * 128 + tcol + 4 * n) * 4) = acc[ai][bj][3][n];
                } }
            if (wr == 1) {
#pragma unroll
                for (int bj = 0; bj < 2; ++bj)
#pragma unroll
                    for (int n = 0; n < 2; ++n) *(f32x4*)(ubuf + ((size_t)((u.pm * 4 + 2 + (fr - 14)) * 2 + bj)) * 5632 + ch0 + 4 * n) = acc[1][bj][3][n];
            }
        }
        if (wr == 0 && fr < 2) {
#pragma unroll
            for (int bj = 0; bj < 2; ++bj)
#pragma unroll
                for (int n = 0; n < 2; ++n) *(f32x4*)(ubuf + ((size_t)((u.pm * 4 + fr) * 2 + bj)) * 5632 + ch0 + 4 * n) = acc[0][bj][0][n];
        }
        asm volatile("s_waitcnt lgkmcnt(0)" ::: "memory"); __builtin_amdgcn_s_barrier(); asm volatile("" ::: "memory");
        const bool f1 = fr >= 1, f2 = fr >= 2;
#pragma unroll
        for (int n = 0; n < 2; ++n) {
            f32x4 w0[2], w1[2], w2[2], bb[2];
#pragma unroll
            for (int bj = 0; bj < 2; ++bj) { const int ci = bj * 5632 + ch0 + 4 * n;
                w0[bj] = *(const f32x4*)(cw + ci); w1[bj] = *(const f32x4*)(cw + 11264 + ci); w2[bj] = *(const f32x4*)(cw + 22528 + ci); bb[bj] = *(const f32x4*)(cb + ci); }
#pragma unroll
            for (int ai = 0; ai < 2; ++ai) { const int blk = 2 * ai + wr;
                f32x4 H[2];
#pragma unroll
                for (int bj = 0; bj < 2; ++bj) { H[bj] = (f32x4){0.f, 0.f, 0.f, 0.f};
                    if (blk > 0 && fr >= 14) H[bj] = *(const PG8_LAS f32x4*)(halo + (size_t)((((blk - 1) * 2 + (fr - 14)) * 256) + bj * 128 + tcol + 4 * n) * 4); }
#pragma unroll
                for (int m = 0; m < 4; ++m) {
                    f32x4 y[2];
#pragma unroll
                    for (int bj = 0; bj < 2; ++bj) { const f32x4 cur = acc[ai][bj][m][n]; f32x4 prv; if (m == 0) prv = H[bj]; else prv = acc[ai][bj][m > 0 ? m - 1 : 0][n];
#pragma unroll
                        for (int e = 0; e < 4; ++e) { const float c1 = dpp_ror1(cur[e]), p1 = dpp_ror1(prv[e]), c2 = dpp_ror2(cur[e]), p2 = dpp_ror2(prv[e]);
                            const float a1 = f1 ? c1 : p1, a2 = f2 ? c2 : p2;
                            y[bj][e] = fmaf(w2[bj][e], cur[e], fmaf(w1[bj][e], a1, fmaf(w0[bj][e], a2, bb[bj][e]))); } }
                    float o[4];
#pragma unroll
                    for (int e = 0; e < 4; ++e) { const float g = y[0][e]; const float sg = g * __builtin_amdgcn_rcpf(1.0f + __builtin_amdgcn_exp2f(-1.4426950408889634f * g)); o[e] = sg * y[1][e]; }
                    u32x2 w; w.x = cvt_pk_bf16(o[0], o[1]); w.y = cvt_pk_bf16(o[2], o[3]);
                    *(u32x2*)(act + (size_t)(u.pm * BM + ai * HALF + wr * 64 + m * 16 + fr) * 5632 + ch0 + 4 * n) = w;
                }
            }
            asm volatile("" ::: "memory");
        }
    }
};
template <class Epi, class Sched, bool ALIGN_EPI = false, bool SP2 = false>
__device__ __forceinline__ void gemm_phase(PG8_LAS unsigned char* lds, const Gemm g, const Sched& S, const Epi& E) {
    const int tid = opaque_tid(), wid = __builtin_amdgcn_readfirstlane(tid >> 6), lane = tid & 63, wr = wid >> 2, wc = wid & 3, fr = lane & 15, fq = lane >> 4;
    const int K = g.K, nt = K / BK;
    unsigned voffA[2], voffB[2];
#pragma unroll
    for (int i = 0; i < 2; ++i) { int R, C; stage_rc(tid * 16 + i * 8192, R, C); const int Rb = Epi::PERM ? ((R & ~31) + perm32(R & 31)) : R;
        voffA[i] = (unsigned)(R * K + C) * 2u; voffB[i] = (unsigned)(Rb * K + C) * 2u; }
    const size_t kstep = (size_t)(BK * 2);
    const size_t hstep = (size_t)HALF * K * 2;
    const size_t tstep = 2 * hstep;
    const unsigned ldsw = (unsigned)wid * 1024u;
    const int aoff = lds_byte(wr * 64 + fr, fq * 8), boff = lds_byte(wc * 32 + fr, fq * 8);
#define PG8_SA(b, h) (((b) * 2 + (h)) * HTB)
#define PG8_SB(b, h) ((4 + (b) * 2 + (h)) * HTB)
#define PG8_STAGE(bufoff, gbase, voff) do { _Pragma("unroll") for (int _i = 0; _i < 2; ++_i) \
        __builtin_amdgcn_global_load_lds((const unsigned*)((const char*)(gbase) + (voff)[_i]), (PG8_LAS unsigned*)(lds + (bufoff) + ldsw + _i * 8192), 16, 0, 0); } while (0)
#define PG8_LDA(dst, b, h) do { _Pragma("unroll") for (int m = 0; m < 4; ++m) _Pragma("unroll") for (int k = 0; k < 2; ++k) dst[m][k] = *(const PG8_LAS bf16x8*)(lds + PG8_SA(b, h) + aoff + m * 2048 + k * 1024); } while (0)
#define PG8_LDB(dst, b, h) do { _Pragma("unroll") for (int n = 0; n < 2; ++n) _Pragma("unroll") for (int k = 0; k < 2; ++k) dst[n][k] = *(const PG8_LAS bf16x8*)(lds + PG8_SB(b, h) + boff + n * 2048 + k * 1024); } while (0)
#define PG8_MMA(ai, bj, At, Bt) do { __builtin_amdgcn_s_setprio(1); _Pragma("unroll") for (int m = 0; m < 4; ++m) _Pragma("unroll") for (int n = 0; n < 2; ++n) _Pragma("unroll") for (int k = 0; k < 2; ++k) \
        acc[ai][bj][m][n] = __builtin_amdgcn_mfma_f32_16x16x32_bf16(Bt[n][k], At[m][k], acc[ai][bj][m][n], 0, 0, 0); __builtin_amdgcn_s_setprio(0); } while (0)
#define PG8_WAIT_V(n) asm volatile("s_waitcnt vmcnt(" #n ")" ::: "memory")
#define PG8_WAIT_L(n) asm volatile("s_waitcnt lgkmcnt(" #n ")" ::: "memory")
#define PG8_BAR __builtin_amdgcn_s_barrier()
#define PG8_SCHED __builtin_amdgcn_sched_barrier(0)
    Unit cur, nxt; int ui = 0;
    if (!S.next(0, cur)) return;
    f32x4 acc[2][2][4][2];
#pragma unroll
    for (int a = 0; a < 2; ++a)
#pragma unroll
        for (int b = 0; b < 2; ++b)
#pragma unroll
            for (int m = 0; m < 4; ++m)
#pragma unroll
                for (int n = 0; n < 2; ++n) acc[a][b][m][n] = (f32x4){0.f, 0.f, 0.f, 0.f};
    bf16x8 At[4][2], B0[2][2], B1[2][2];
    const char* cA = (const char*)g.A + (size_t)cur.pm * tstep; const char* cB = (const char*)g.Bt + (size_t)cur.pn * tstep;
    S.a_ready(cur);
    if constexpr (SP2) {
        PG8_STAGE(PG8_SB(0, 0), cB, voffB); PG8_STAGE(PG8_SB(0, 1), cB + hstep, voffB); PG8_STAGE(PG8_SA(0, 0), cA, voffA); PG8_STAGE(PG8_SA(0, 1), cA + hstep, voffA);
        if (wr == 1) PG8_BAR;
        PG8_WAIT_V(2); PG8_BAR;
        PG8_STAGE(PG8_SB(1, 0), cB + kstep, voffB); PG8_STAGE(PG8_SA(1, 0), cA + kstep, voffA); PG8_STAGE(PG8_SB(1, 1), cB + hstep + kstep, voffB);
        PG8_WAIT_V(6); PG8_BAR;
    } else {
        PG8_STAGE(PG8_SB(0, 0), cB, voffB); PG8_STAGE(PG8_SA(0, 0), cA, voffA); PG8_STAGE(PG8_SB(0, 1), cB + hstep, voffB); PG8_STAGE(PG8_SA(0, 1), cA + hstep, voffA);
        if (wr == 1) PG8_BAR;
        PG8_WAIT_V(4); PG8_BAR;
        PG8_STAGE(PG8_SB(1, 0), cB + kstep, voffB); PG8_STAGE(PG8_SA(1, 0), cA + kstep, voffA); PG8_STAGE(PG8_SB(1, 1), cB + hstep + kstep, voffB);
        PG8_WAIT_V(6); PG8_BAR;
    }
    for (;;) {
        const bool has_next = S.next(ui + 1, nxt);
        const char* nA = has_next ? (const char*)g.A + (size_t)nxt.pm * tstep : cA; const char* nB = has_next ? (const char*)g.Bt + (size_t)nxt.pn * tstep : cB;
        for (int t = 0; t < nt; t += 2) {
            const bool last = (t == nt - 2);
            const char* a1 = cA + (size_t)(t + 1) * kstep;
            const char* a2 = last ? nA : cA + (size_t)(t + 2) * kstep; const char* b2 = last ? nB : cB + (size_t)(t + 2) * kstep;
            const char* a3 = a2 + kstep; const char* b3 = b2 + kstep;
            if (last && has_next) S.a_ready(nxt);
            if constexpr (SP2) {
            PG8_LDB(B0, 0, 0); PG8_LDB(B1, 0, 1); PG8_SCHED; PG8_LDA(At, 0, 0); PG8_STAGE(PG8_SA(1, 1), a1 + hstep, voffA);
            PG8_WAIT_V(8); PG8_WAIT_L(0); PG8_BAR; PG8_MMA(0, 0, At, B0); PG8_MMA(0, 1, At, B1); PG8_BAR; PG8_SCHED;
            PG8_LDA(At, 0, 1); PG8_STAGE(PG8_SB(0, 0), b2, voffB); PG8_STAGE(PG8_SB(0, 1), b2 + hstep, voffB); PG8_STAGE(PG8_SA(0, 0), a2, voffA);
            PG8_WAIT_V(8); PG8_WAIT_L(0); PG8_BAR; PG8_MMA(1, 0, At, B0); PG8_MMA(1, 1, At, B1); PG8_BAR; PG8_SCHED;
            PG8_LDB(B0, 1, 0); PG8_LDB(B1, 1, 1); PG8_SCHED; PG8_LDA(At, 1, 0); PG8_STAGE(PG8_SA(0, 1), a2 + hstep, voffA);
            PG8_WAIT_V(8); PG8_WAIT_L(0); PG8_BAR; PG8_MMA(0, 0, At, B0); PG8_MMA(0, 1, At, B1); PG8_BAR; PG8_SCHED;
            PG8_LDA(At, 1, 1); PG8_STAGE(PG8_SB(1, 0), b3, voffB); PG8_STAGE(PG8_SB(1, 1), b3 + hstep, voffB); PG8_STAGE(PG8_SA(1, 0), a3, voffA);
            PG8_WAIT_V(8); PG8_WAIT_L(0); PG8_BAR; PG8_MMA(1, 0, At, B0); PG8_MMA(1, 1, At, B1); PG8_BAR; PG8_SCHED;
            } else {
            PG8_LDB(B0, 0, 0); PG8_SCHED; PG8_LDA(At, 0, 0); PG8_STAGE(PG8_SA(1, 1), a1 + hstep, voffA);
            PG8_WAIT_L(8); PG8_BAR; PG8_WAIT_L(0); PG8_MMA(0, 0, At, B0); PG8_BAR; PG8_SCHED;
            PG8_LDB(B1, 0, 1); PG8_STAGE(PG8_SB(0, 0), b2, voffB);
            PG8_BAR; PG8_WAIT_L(0); PG8_MMA(0, 1, At, B1); PG8_BAR;
            PG8_LDA(At, 0, 1); PG8_STAGE(PG8_SA(0, 0), a2, voffA);
            PG8_BAR; PG8_WAIT_L(0); PG8_MMA(1, 0, At, B0); PG8_BAR; PG8_SCHED;
            PG8_STAGE(PG8_SB(0, 1), b2 + hstep, voffB);
            PG8_WAIT_V(6); PG8_BAR; PG8_MMA(1, 1, At, B1); PG8_BAR;
            PG8_LDB(B0, 1, 0); PG8_SCHED; PG8_LDA(At, 1, 0); PG8_STAGE(PG8_SA(0, 1), a2 + hstep, voffA);
            PG8_WAIT_L(8); PG8_BAR; PG8_WAIT_L(0); PG8_MMA(0, 0, At, B0); PG8_BAR; PG8_SCHED;
            PG8_LDB(B1, 1, 1); PG8_STAGE(PG8_SB(1, 0), b3, voffB);
            PG8_BAR; PG8_WAIT_L(0); PG8_MMA(0, 1, At, B1); PG8_BAR;
            PG8_LDA(At, 1, 1); PG8_STAGE(PG8_SA(1, 0), a3, voffA);
            PG8_BAR; PG8_WAIT_L(0); PG8_MMA(1, 0, At, B0); PG8_BAR; PG8_SCHED;
            PG8_STAGE(PG8_SB(1, 1), b3 + hstep, voffB);
            PG8_WAIT_V(6); PG8_BAR; PG8_MMA(1, 1, At, B1); PG8_BAR;
            }
        }
        if constexpr (ALIGN_EPI) { if (wr == 0) PG8_BAR; }
        if constexpr (!Epi::AFTER_DRAIN) { E(acc, cur, wr, wc, fr, fq); S.done(cur); }
        if (!has_next) break;
#pragma unroll
        for (int a = 0; a < 2; ++a)
#pragma unroll
            for (int b = 0; b < 2; ++b)
#pragma unroll
                for (int m = 0; m < 4; ++m)
#pragma unroll
                    for (int n = 0; n < 2; ++n) acc[a][b][m][n] = (f32x4){0.f, 0.f, 0.f, 0.f};
        cur = nxt; cA = nA; cB = nB; ++ui;
        if constexpr (ALIGN_EPI) { if (wr == 1) PG8_BAR; }
    }
    PG8_WAIT_V(0);
    if constexpr (!ALIGN_EPI) { if (wr == 0) PG8_BAR; }
    PG8_BAR;
    if constexpr (Epi::AFTER_DRAIN) { E.fused(acc, cur, wr, wc, fr, fq, lds, wid, lane); S.done(cur); }
#undef PG8_SA
#undef PG8_SB
#undef PG8_STAGE
#undef PG8_LDA
#undef PG8_LDB
#undef PG8_MMA
#undef PG8_WAIT_V
#undef PG8_WAIT_L
#undef PG8_BAR
#undef PG8_SCHED
}
}
namespace fox {
typedef unsigned short bf16;
typedef short bf16x8 __attribute__((ext_vector_type(8)));
typedef short s16x4 __attribute__((ext_vector_type(4)));
typedef float f32x16 __attribute__((ext_vector_type(16)));
typedef float f32x4 __attribute__((ext_vector_type(4)));
typedef unsigned u32x4 __attribute__((ext_vector_type(4)));
#define FLAS __attribute__((address_space(3)))
constexpr int D = 128, PITCH = 2048, SEQ = 2048;
constexpr float SCALE = 0.08838834764831845f, INV_SCALE = 11.313708498984761f, THR = 8.f;
constexpr int NW = 8, QBLK = 32, KVBLK = 64, QB = NW * QBLK;
constexpr int SHM_V = KVBLK * D * 2, SHM_K = KVBLK * D * 2;
constexpr int LDS_WS = 2 * SHM_V + 2 * SHM_K, LDS_KB = LDS_WS + NW * 64 * 4, LDS_WT = LDS_KB + 4 * SEQ * 4, LDS_BYTES = LDS_WT + 64;
constexpr int WBIG = 1 << 30;
#define KSWZ(row, colB) ((row) * 256 + ((colB) ^ (((row) & 7) << 4)))
#define SBAR() __builtin_amdgcn_sched_barrier(0)
__device__ __forceinline__ int v_st(int k, int c) { const int kk = (k & ~0xC) | ((k & 4) << 1) | ((k & 8) >> 1); return ((kk >> 3) * 4 + (c >> 5)) * 512 + ((kk & 7) * 32 + (c & 31)) * 2; }
__device__ __forceinline__ int v_rd_base(int lane) { return ((lane & 3) << 3) | (((lane >> 2) & 3) << 6) | (((lane >> 4) & 1) << 5) | (((lane >> 5) & 1) << 8); }
constexpr int v_rd_off(int d0, int ks, int half) { return d0 * 512 + ks * 4096 + half * 2048; }
__device__ __forceinline__ int crow(int r, int hi) { return (r & 3) + 8 * (r >> 2) + 4 * hi; }
__device__ __forceinline__ unsigned cvtpk(float lo, float hi) { unsigned r; asm volatile("v_cvt_pk_bf16_f32 %0, %1, %2" : "=v"(r) : "v"(lo), "v"(hi)); return r; }
__device__ __forceinline__ bf16x8 load8(const bf16* p) { return *reinterpret_cast<const bf16x8*>(p); }
__device__ __forceinline__ void mask_tile(f32x16& p0, f32x16& p1, int dq, unsigned W) {
    const float NEG = -__builtin_inff();
#pragma unroll
    for (int r = 0; r < 16; ++r) {
        const int c = (r & 3) + 8 * (r >> 2);
        if ((unsigned)(dq - c) >= W) p0[r] = NEG;
        if ((unsigned)(dq - c - 32) >= W) p1[r] = NEG;
    }
}
__device__ __forceinline__ void partialSM(f32x16& p0, f32x16& p1, float& m_reg, float& mn, float& alpha) {
    float pmax = p0[0];
#pragma unroll
    for (int r = 1; r < 16; ++r) pmax = fmaxf(pmax, p0[r]);
#pragma unroll
    for (int r = 0; r < 16; ++r) pmax = fmaxf(pmax, p1[r]);
    { auto rr = __builtin_amdgcn_permlane32_swap(__float_as_uint(pmax), __float_as_uint(pmax), false, false);
      pmax = fmaxf(__uint_as_float(rr[0]), __uint_as_float(rr[1])); }
    constexpr float C2 = 1.4426950408889634f * SCALE;
    if (__builtin_expect(__all((pmax - m_reg) * SCALE <= THR), 1)) { mn = m_reg; alpha = 1.f; }
    else { mn = fmaxf(m_reg, pmax); alpha = __builtin_amdgcn_exp2f((m_reg - mn) * C2); m_reg = mn; }
    const float mnL = -mn * C2;
#pragma unroll
    for (int r = 0; r < 16; ++r) p0[r] = fmaf(p0[r], C2, mnL);
#pragma unroll
    for (int r = 0; r < 16; ++r) p1[r] = fmaf(p1[r], C2, mnL);
#pragma unroll
    for (int r = 0; r < 16; ++r) p0[r] = __builtin_amdgcn_exp2f(p0[r]);
}
#define PK4(P, B_, OUT) do { unsigned a0 = cvtpk(P[B_+0], P[B_+1]), a1 = cvtpk(P[B_+2], P[B_+3]);                          \
        unsigned b0 = cvtpk(P[B_+4], P[B_+5]), b1 = cvtpk(P[B_+6], P[B_+7]);                                             \
        auto r0 = __builtin_amdgcn_permlane32_swap(a0, b0, false, false); auto r1 = __builtin_amdgcn_permlane32_swap(a1, b1, false, false); \
        u32x4 w = {r0[0], r1[0], r0[1], r1[1]}; OUT = *reinterpret_cast<bf16x8*>(&w); } while (0)
__device__ __forceinline__ void finishSM(f32x16& p0, f32x16& p1, float alpha, float& l_reg, bf16x8& pa0, bf16x8& pa1, bf16x8& pa2, bf16x8& pa3) {
#pragma unroll
    for (int r = 0; r < 16; ++r) p1[r] = __builtin_amdgcn_exp2f(p1[r]);
    float ps = 0;
#pragma unroll
    for (int r = 0; r < 16; ++r) ps += p0[r];
#pragma unroll
    for (int r = 0; r < 16; ++r) ps += p1[r];
    { auto rr = __builtin_amdgcn_permlane32_swap(__float_as_uint(ps), __float_as_uint(ps), false, false);
      ps = __uint_as_float(rr[0]) + __uint_as_float(rr[1]); }
    l_reg = l_reg * alpha + ps;
    PK4(p0, 0, pa0); PK4(p0, 8, pa1); PK4(p1, 0, pa2); PK4(p1, 8, pa3);
}
template <int KB>
__device__ __forceinline__ void qkt(f32x16& p0, f32x16& p1, const char* K_lds, int r32, int hi, const bf16x8* qr, const FLAS float* kbp) {
#pragma unroll
    for (int g = 0; g < 4; ++g) { const f32x4 v0 = *(const FLAS f32x4*)(kbp + 8 * g), v1 = *(const FLAS f32x4*)(kbp + 32 + 8 * g);
#pragma unroll
        for (int e = 0; e < 4; ++e) { p0[4 * g + e] = v0[e]; p1[4 * g + e] = v1[e]; } }
    const char* kb[4];
#pragma unroll
    for (int dd = 0; dd < 4; ++dd) kb[dd] = K_lds + KB * SHM_K + KSWZ(r32, (dd * 16 + hi * 8) * 2);
#pragma unroll
    for (int d0 = 0; d0 < 8; ++d0) { const char* a = kb[d0 & 3] + (d0 >> 2) * 128;
        bf16x8 b0 = *reinterpret_cast<const bf16x8*>(a);
        bf16x8 b1 = *reinterpret_cast<const bf16x8*>(a + 32 * 256);
        p0 = __builtin_amdgcn_mfma_f32_32x32x16_bf16(b0, qr[d0], p0, 0, 0, 0);
        p1 = __builtin_amdgcn_mfma_f32_32x32x16_bf16(b1, qr[d0], p1, 0, 0, 0); }
}
template <int VB>
__device__ __forceinline__ void pv_tile(f32x16* o, int vb0, bf16x8 pa0, bf16x8 pa1, bf16x8 pa2, bf16x8 pa3) {
#define TRRD(dst, off) asm volatile("ds_read_b64_tr_b16 %0, %1 offset:%2" : "=&v"(dst) : "v"(vb0), "i"(off) : "memory")
#define PV_D0(d0) do { s16x4 l0, l1, l2, l3, h0, h1, h2, h3; constexpr int b_ = VB * SHM_V + v_rd_off(d0, 0, 0); \
        TRRD(l0, b_); TRRD(h0, b_ + 2048); TRRD(l1, b_ + 4096); TRRD(h1, b_ + 6144); TRRD(l2, b_ + 8192); TRRD(h2, b_ + 10240); TRRD(l3, b_ + 12288); TRRD(h3, b_ + 14336); \
        asm volatile("s_waitcnt lgkmcnt(0)" ::: "memory"); SBAR(); \
        o[d0] = __builtin_amdgcn_mfma_f32_32x32x16_bf16(pa0, (bf16x8){l0[0], l0[1], l0[2], l0[3], h0[0], h0[1], h0[2], h0[3]}, o[d0], 0, 0, 0);   \
        o[d0] = __builtin_amdgcn_mfma_f32_32x32x16_bf16(pa1, (bf16x8){l1[0], l1[1], l1[2], l1[3], h1[0], h1[1], h1[2], h1[3]}, o[d0], 0, 0, 0);   \
        o[d0] = __builtin_amdgcn_mfma_f32_32x32x16_bf16(pa2, (bf16x8){l2[0], l2[1], l2[2], l2[3], h2[0], h2[1], h2[2], h2[3]}, o[d0], 0, 0, 0);   \
        o[d0] = __builtin_amdgcn_mfma_f32_32x32x16_bf16(pa3, (bf16x8){l3[0], l3[1], l3[2], l3[3], h3[0], h3[1], h3[2], h3[3]}, o[d0], 0, 0, 0); } while (0)
    PV_D0(0); PV_D0(1); PV_D0(2); PV_D0(3);
#undef PV_D0
#undef TRRD
}
struct BlockRef { const bf16* Q; const bf16* K; const bf16* V; bf16* O; const float* lf; int P0; };
struct Seam { bf16x8 qr[8]; bf16x8 st_v0, st_v1, st_k0, st_k1; };
#define ROW(p, k0, rr) ((p) + (size_t)((k0) + (rr)) * PITCH + sc)
#define VMW() asm volatile("s_waitcnt vmcnt(0)" ::: "memory")
#define VMWN(n) asm volatile("s_waitcnt vmcnt(%0)" :: "i"(n) : "memory")
#define SLOAD_H(Kp, Vp, k0) do { const bf16* kq_ = (Kp) + (size_t)(k0) * PITCH; const bf16* vq_ = (Vp) + (size_t)(k0) * PITCH; \
                         S.st_v0 = load8(vq_ + soff); S.st_v1 = load8(vq_ + 32 * PITCH + soff); S.st_k0 = load8(kq_ + soff); S.st_k1 = load8(kq_ + 32 * PITCH + soff); } while (0)
#define SWRITE_HK(bf) do { *(bf16x8*)(K_lds + (bf) * SHM_K + kws) = S.st_k0; *(bf16x8*)(K_lds + (bf) * SHM_K + kws + 32 * 256) = S.st_k1; } while (0)
#define SWRITE_HV(bf) do { *(bf16x8*)(V_lds + (bf) * SHM_V + vst0) = S.st_v0; *(bf16x8*)(V_lds + (bf) * SHM_V + vst1) = S.st_v1; } while (0)
#define SWRITE_H(bf) do { SWRITE_HV(bf); SWRITE_HK(bf); } while (0)
__device__ __forceinline__ void prime(const BlockRef& cur, char* lds, Seam& S) {
    const int tid = opaque_tid(), wid = __builtin_amdgcn_readfirstlane(tid >> 6), lane = tid & 63, r32 = lane & 31, hi = lane >> 5;
    const int sr = tid >> 4, sc = (tid & 15) * 8, kws = KSWZ(sr, sc * 2); char* K_lds = lds + 2 * SHM_V; const unsigned soff = sr * PITCH + sc, qoff = r32 * PITCH + hi * 8;
    { const bf16* qb_ = cur.Q + (size_t)(wid * QBLK) * PITCH;
#pragma unroll
    for (int d0 = 0; d0 < 8; ++d0) S.qr[d0] = load8(qb_ + qoff + d0 * 16); }
    SLOAD_H(cur.K, cur.V, 0); VMW(); SWRITE_HK(0);
    __syncthreads();
}
__device__ __forceinline__ void key_bias(const BlockRef& cur, char* lds, int slot) {
    const int tid = opaque_tid(), wid = __builtin_amdgcn_readfirstlane(tid >> 6), lane = tid & 63;
    FLAS float* kb = (FLAS float*)(lds + LDS_KB) + slot * SEQ; FLAS float* wt = (FLAS float*)(lds + LDS_WT);
    const int n = cur.P0 + QB; const bool act = 4 * tid < n;
    float lf[4];
#pragma unroll
    for (int j = 0; j < 4; ++j) lf[j] = act ? cur.lf[(size_t)(4 * tid + j) * 16] : 0.f;
    lf[1] += lf[0]; lf[2] += lf[1]; lf[3] += lf[2];
    float tot = lf[3];
#pragma unroll
    for (int o = 1; o < 64; o <<= 1) { const float t = __shfl_up(tot, o); if (lane >= o) tot += t; }
    if (lane == 63) wt[wid] = tot;
    __syncthreads();
    float off = tot - lf[3];
#pragma unroll
    for (int w = 0; w < 8; ++w) { const float t = wt[w]; if (w < wid) off += t; }
    if (4 * tid == cur.P0) wt[8] = off + lf[0];
    __syncthreads();
    const float cref = wt[8];
    f32x4 o4; o4[0] = (cref - (off + lf[0])) * INV_SCALE; o4[1] = (cref - (off + lf[1])) * INV_SCALE; o4[2] = (cref - (off + lf[2])) * INV_SCALE; o4[3] = (cref - (off + lf[3])) * INV_SCALE;
    *(FLAS f32x4*)(kb + 4 * tid) = o4;
    __syncthreads();
}
__device__ __forceinline__ void block(const BlockRef& cur, const BlockRef& nxt, char* lds, Seam& S, int slot) {
    const int tid = opaque_tid(), wid = __builtin_amdgcn_readfirstlane(tid >> 6), lane = tid & 63, r32 = lane & 31, hi = lane >> 5;
    constexpr int W = WBIG;
    const int NT = (cur.P0 + QB - 1) / KVBLK + 1;
    const int qlo = cur.P0 + wid * QBLK, qm = qlo + r32 - 4 * hi;
    char* V_lds = lds; char* K_lds = lds + 2 * SHM_V;
    float* ws = (float*)(lds + LDS_WS) + wid * 64; float* li_l = ws, * al_l = ws + 32;
    const FLAS float* kbl = (const FLAS float*)(lds + LDS_KB) + slot * SEQ + 4 * hi;
    float m_reg = -1e30f, l_reg = 0; f32x16 o[4] = {};
    const int sr = tid >> 4, sc = (tid & 15) * 8, vst0 = v_st(sr, sc), vst1 = v_st(32 + sr, sc), kws = KSWZ(sr, sc * 2); const unsigned soff = sr * PITCH + sc, qoff = r32 * PITCH + hi * 8;
    const int vb0 = (int)(uintptr_t)V_lds + v_rd_base(lane);
    const bf16* Kh = cur.K; const bf16* Vh = cur.V;
#define RESC(a) do { if (__any((a) < 1.f)) { if (hi == 0) al_l[r32] = (a); asm volatile("s_waitcnt lgkmcnt(0)" ::: "memory");              \
                     for (int d_ = 0; d_ < 4; ++d_) for (int r = 0; r < 16; ++r) o[d_][r] *= al_l[crow(r, hi)]; } } while (0)
#define KBASE(t) ((t) * KVBLK)
#define MASKT(P0_, P1_, t) do { const int kb_ = KBASE(t); if (kb_ + KVBLK - 1 > qlo) mask_tile(P0_, P1_, qm - kb_, (unsigned)W); } while (0)
#define SEAM_K0() do { VMWN(8); SWRITE_HK(0); SBAR(); } while (0)
    f32x16 pA0, pA1, pB0, pB1; float mnA, mnB, alA, alB; bf16x8 pa0, pa1, pa2, pa3;
    SWRITE_HV(0); SBAR();
    if (NT > 1) { SLOAD_H(Kh, Vh, KBASE(1)); }
    SBAR(); qkt<0>(pA0, pA1, K_lds, r32, hi, S.qr, kbl + KBASE(0));
    MASKT(pA0, pA1, 0); partialSM(pA0, pA1, m_reg, mnA, alA);
    if (NT > 1) { VMW(); SWRITE_H(1); }
    __syncthreads();
#define HALF_STEP(PX0, PX1, mnX, alX, PY0, PY1, alY, t, KB, VB, SB) do {                                                      \
        SBAR(); qkt<KB>(PX0, PX1, K_lds, r32, hi, S.qr, kbl + KBASE(t));                                                          \
        finishSM(PY0, PY1, alY, l_reg, pa0, pa1, pa2, pa3); SBAR();                                                           \
        if ((t) + 1 < NT) { SLOAD_H(Kh, Vh, KBASE((t) + 1)); SBAR(); }                                               \
        pv_tile<VB>(o, vb0, pa0, pa1, pa2, pa3); MASKT(PX0, PX1, (t)); partialSM(PX0, PX1, m_reg, mnX, alX);   \
        __syncthreads();                                                                                                      \
        if ((t) + 1 < NT) { VMW(); SWRITE_H(SB); }                                                                          \
        RESC(alX); __syncthreads(); } while (0)
    for (int t = 1; t + 1 < NT; t += 2) {
        HALF_STEP(pB0, pB1, mnB, alB, pA0, pA1, alA, t, 1, 0, 0);
        HALF_STEP(pA0, pA1, mnA, alA, pB0, pB1, alB, t + 1, 0, 1, 1);
    }
    const bool even = (NT & 1) == 0;
    if (even) { SBAR(); qkt<1>(pB0, pB1, K_lds, r32, hi, S.qr, kbl + KBASE(NT - 1)); SBAR(); }
    SLOAD_H(nxt.K, nxt.V, 0); SBAR();
    { const bf16* qb_ = nxt.Q + (size_t)(wid * QBLK) * PITCH;
#pragma unroll
    for (int d0 = 0; d0 < 8; ++d0) S.qr[d0] = load8(qb_ + qoff + d0 * 16); }
    SBAR();
    finishSM(pA0, pA1, alA, l_reg, pa0, pa1, pa2, pa3); SBAR();
    pv_tile<0>(o, vb0, pa0, pa1, pa2, pa3);
    if (even) { MASKT(pB0, pB1, NT - 1); partialSM(pB0, pB1, m_reg, mnB, alB); __syncthreads(); RESC(alB);
        finishSM(pB0, pB1, alB, l_reg, pa0, pa1, pa2, pa3); SBAR(); pv_tile<1>(o, vb0, pa0, pa1, pa2, pa3); }
    SBAR(); SEAM_K0();
    if (hi == 0) li_l[r32] = l_reg; asm volatile("s_waitcnt lgkmcnt(0)" ::: "memory");
    float rli[16];
#pragma unroll
    for (int r = 0; r < 16; ++r) rli[r] = __builtin_amdgcn_rcpf(li_l[crow(r, hi)]);
    bf16* Ow = cur.O + (size_t)(wid * QBLK) * PITCH; const unsigned ooff = 4 * hi * PITCH + r32;
#pragma unroll
    for (int r = 0; r < 16; ++r) { const int orow = crow(r, hi);
#pragma unroll
        for (int d0 = 0; d0 < 4; ++d0) { const float v = o[d0][r] * rli[r];
            const float vn = __shfl_xor(v, 1);
            if ((r32 & 1) == 0) *(unsigned*)(Ow + ((r & 3) + 8 * (r >> 2)) * PITCH + d0 * 32 + ooff) = cvtpk(v, vn); } }
    __syncthreads();
#undef RESC
#undef KBASE
#undef MASKT
#undef SEAM_K0
#undef HALF_STEP
}
#undef ROW
#undef VMW
#undef VMWN
#undef SLOAD_H
#undef SWRITE_HK
#undef SWRITE_HV
#undef SWRITE_H
}
namespace swa {
typedef unsigned short bf16;
typedef short bf16x8 __attribute__((ext_vector_type(8)));
typedef short s16x4 __attribute__((ext_vector_type(4)));
typedef float f32x16 __attribute__((ext_vector_type(16)));
typedef float f32x4 __attribute__((ext_vector_type(4)));
typedef unsigned u32x4 __attribute__((ext_vector_type(4)));
#define SLAS __attribute__((address_space(3)))
using fox::cvtpk;
constexpr int QKVP = 2560, OP = 2048, KROW = 144;
constexpr int LDS_K = 0, LDS_V = 256 * KROW, LDS_WS = LDS_V + 256 * 64 * 2, LDS_BYTES = LDS_WS + 8 * 256;
__device__ __forceinline__ int v_st2(int k, int c) { const int kk = (k & ~0xC) | ((k & 4) << 1) | ((k & 8) >> 1); return ((kk >> 3) * 2 + (c >> 5)) * 512 + ((kk & 7) * 32 + (c & 31)) * 2; }
__device__ __forceinline__ float bf_lo(unsigned w) { return __uint_as_float(w << 16); }
__device__ __forceinline__ float bf_hi(unsigned w) { return __uint_as_float(w & 0xffff0000u); }
__device__ __forceinline__ u32x4 rope8(u32x4 own, u32x4 oth, const float* tab, bool second) {
    const f32x4 c0 = *(const f32x4*)(tab), c1 = *(const f32x4*)(tab + 4), s0 = *(const f32x4*)(tab + 8), s1 = *(const f32x4*)(tab + 12);
    const float sg = second ? 1.f : -1.f;
    float cs[8] = {c0[0], c0[1], c0[2], c0[3], c1[0], c1[1], c1[2], c1[3]}, sn[8] = {s0[0], s0[1], s0[2], s0[3], s1[0], s1[1], s1[2], s1[3]};
    u32x4 r;
#pragma unroll
    for (int i = 0; i < 4; ++i) { const float a0 = bf_lo(own[i]), a1 = bf_hi(own[i]), b0 = bf_lo(oth[i]), b1 = bf_hi(oth[i]);
        const float o0 = a0 * cs[2 * i] + sg * b0 * sn[2 * i], o1 = a1 * cs[2 * i + 1] + sg * b1 * sn[2 * i + 1];
        r[i] = fox::cvtpk(o0, o1); }
    return r;
}
__device__ __forceinline__ void unit(int b, int n, int hk, const bf16* QKV, bf16* O, const float* rope, const float* sinks, char* lds) {
    const int tid = opaque_tid(), wid = __builtin_amdgcn_readfirstlane(tid >> 6), lane = tid & 63, r32 = lane & 31, hi = lane >> 5;
    const bf16* base = QKV + (size_t)(b * 2048) * QKVP;
    SLAS char* l3 = (SLAS char*)lds;
#pragma unroll
    for (int i = 0; i < 4; ++i) { const int row = i * 64 + (tid >> 3), c = tid & 7, s = 128 * (n - 1) + row; const bool valid = s >= 0;
        u32x4 kv = {0u, 0u, 0u, 0u}, vv = {0u, 0u, 0u, 0u};
        if (valid) { kv = *(const u32x4*)(base + (size_t)s * QKVP + 2048 + hk * 64 + 8 * c); vv = *(const u32x4*)(base + (size_t)s * QKVP + 2304 + hk * 64 + 8 * c); }
        u32x4 ot; ot[0] = __shfl_xor(kv[0], 1); ot[1] = __shfl_xor(kv[1], 1); ot[2] = __shfl_xor(kv[2], 1); ot[3] = __shfl_xor(kv[3], 1);
        if (c < 2 && valid) kv = rope8(kv, ot, rope + (size_t)(b * 2048 + s) * 16, c == 1);
        *(SLAS u32x4*)(l3 + LDS_K + row * KROW + c * 16) = kv;
        *(SLAS u32x4*)(l3 + LDS_V + v_st2(row, 8 * c)) = vv; }
    __syncthreads();
    const int hq = hk * 8 + wid;
    const float sinkL = sinks[hq] * 1.4426950408889634f;
    constexpr float C2 = 0.125f * 1.4426950408889634f;
    const int vb0 = LDS_V + fox::v_rd_base(lane);
    SLAS float* li_l = (SLAS float*)(l3 + LDS_WS + wid * 256);
    for (int c4 = 0; c4 < 4; ++c4) {
        const int qrow = b * 2048 + 128 * n + 32 * c4 + r32;
        bf16x8 qr[4];
#pragma unroll
        for (int ks = 0; ks < 4; ++ks) qr[ks] = *(const bf16x8*)(base + (size_t)(128 * n + 32 * c4 + r32) * QKVP + hq * 64 + 16 * ks + 8 * hi);
        { u32x4 own = __builtin_bit_cast(u32x4, qr[0]); u32x4 ot; ot[0] = __shfl_xor(own[0], 32); ot[1] = __shfl_xor(own[1], 32); ot[2] = __shfl_xor(own[2], 32); ot[3] = __shfl_xor(own[3], 32);
          own = rope8(own, ot, rope + (size_t)qrow * 16, hi == 1); qr[0] = __builtin_bit_cast(bf16x8, own); }
        f32x16 p[5];
#pragma unroll
        for (int jb = 0; jb < 5; ++jb) { p[jb] = f32x16{};
            const SLAS char* kp = l3 + LDS_K + (32 * c4 + 32 * jb + r32) * KROW + hi * 16;
#pragma unroll
            for (int ks = 0; ks < 4; ++ks) { const bf16x8 a = *(const SLAS bf16x8*)(kp + ks * 32); p[jb] = __builtin_amdgcn_mfma_f32_32x32x16_bf16(a, qr[ks], p[jb], 0, 0, 0); } }
        float mx = sinkL;
#pragma unroll
        for (int jb = 0; jb < 5; ++jb) { const bool dead = (n == 0) && (c4 + jb < 4);
#pragma unroll
            for (int r = 0; r < 16; ++r) { const int rel = r32 + 128 - 32 * jb - fox::crow(r, hi); const bool ok = ((unsigned)rel < 128u) && !dead;
                const float t = ok ? p[jb][r] * C2 : -__builtin_inff(); p[jb][r] = t; mx = fmaxf(mx, t); } }
        { auto rr = __builtin_amdgcn_permlane32_swap(__float_as_uint(mx), __float_as_uint(mx), false, false); mx = fmaxf(__uint_as_float(rr[0]), __uint_as_float(rr[1])); }
        float ps = 0.f;
#pragma unroll
        for (int jb = 0; jb < 5; ++jb)
#pragma unroll
            for (int r = 0; r < 16; ++r) { const float e = __builtin_amdgcn_exp2f(p[jb][r] - mx); p[jb][r] = e; ps += e; }
        { auto rr = __builtin_amdgcn_permlane32_swap(__float_as_uint(ps), __float_as_uint(ps), false, false); ps = __uint_as_float(rr[0]) + __uint_as_float(rr[1]); }
        ps += __builtin_amdgcn_exp2f(sinkL - mx);
        f32x16 o[2]; o[0] = f32x16{}; o[1] = f32x16{};
#pragma unroll
        for (int jb = 0; jb < 5; ++jb) { bf16x8 pa0, pa1; PK4(p[jb], 0, pa0); PK4(p[jb], 8, pa1);
            const SLAS char* vp = l3 + vb0 + (2 * c4 + 2 * jb) * 2048;
#pragma unroll
            for (int d0 = 0; d0 < 2; ++d0) {
                const s16x4 l0 = __builtin_bit_cast(s16x4, __builtin_amdgcn_ds_read_tr16_b64_v4i16((SLAS s16x4*)(vp + d0 * 512)));
                const s16x4 h0 = __builtin_bit_cast(s16x4, __builtin_amdgcn_ds_read_tr16_b64_v4i16((SLAS s16x4*)(vp + d0 * 512 + 1024)));
                const s16x4 l1 = __builtin_bit_cast(s16x4, __builtin_amdgcn_ds_read_tr16_b64_v4i16((SLAS s16x4*)(vp + d0 * 512 + 2048)));
                const s16x4 h1 = __builtin_bit_cast(s16x4, __builtin_amdgcn_ds_read_tr16_b64_v4i16((SLAS s16x4*)(vp + d0 * 512 + 3072)));
                o[d0] = __builtin_amdgcn_mfma_f32_32x32x16_bf16(pa0, (bf16x8){l0[0], l0[1], l0[2], l0[3], h0[0], h0[1], h0[2], h0[3]}, o[d0], 0, 0, 0);
                o[d0] = __builtin_amdgcn_mfma_f32_32x32x16_bf16(pa1, (bf16x8){l1[0], l1[1], l1[2], l1[3], h1[0], h1[1], h1[2], h1[3]}, o[d0], 0, 0, 0); } }
        if (hi == 0) li_l[r32] = ps;
        asm volatile("s_waitcnt lgkmcnt(0)" ::: "memory");
        bf16* Ow = O + (size_t)(b * 2048 + 128 * n + 32 * c4) * OP + hq * 64;
#pragma unroll
        for (int r = 0; r < 16; ++r) { const int orow = fox::crow(r, hi); const float rl = __builtin_amdgcn_rcpf(li_l[orow]);
#pragma unroll
            for (int d0 = 0; d0 < 2; ++d0) { const float v = o[d0][r] * rl; const float vn = __shfl_xor(v, 1);
                if ((r32 & 1) == 0) *(unsigned*)(Ow + (size_t)orow * OP + d0 * 32 + r32) = fox::cvtpk(v, vn); } }
        asm volatile("s_waitcnt lgkmcnt(0)" ::: "memory");
    }
    __syncthreads();
}
}
#define LAS __attribute__((address_space(3)))
typedef unsigned short bf16_t;
typedef float f32x4 __attribute__((ext_vector_type(4)));
typedef unsigned u32x4 __attribute__((ext_vector_type(4)));
typedef unsigned u32x2 __attribute__((ext_vector_type(2)));
typedef short bf16x8 __attribute__((ext_vector_type(8)));
constexpr int M = 16384, DM = 2048, SEQ = 2048, NB = 8, DFF = 5632, NFIN = 6160, NSIN = 2560;
constexpr float LN_EPS = 1e-5f, ALPHA = 1.4142135623730951f;
constexpr size_t MiB = 1u << 20;
constexpr size_t WS_MOD = 1 * MiB;
constexpr size_t WS_ROPE = 2 * MiB;
constexpr size_t WS_LOGF = 3 * MiB;
constexpr size_t WS_UBUF = 4 * MiB;
constexpr size_t WS_WFIN = 16 * MiB;
constexpr size_t WS_WFO = 42 * MiB;
constexpr size_t WS_WSIN = 50 * MiB;
constexpr size_t WS_WSO = 60 * MiB;
constexpr size_t WS_WUP = 68 * MiB;
constexpr size_t WS_WDN = 156 * MiB;
constexpr size_t WS_H = 200 * MiB;
constexpr size_t WS_Z = 264 * MiB;
constexpr size_t WS_Q = 392 * MiB;
constexpr size_t WS_K = 456 * MiB, WS_V = 520 * MiB;
constexpr size_t WS_O = 584 * MiB;
constexpr size_t WS_END = 648 * MiB;
constexpr int LDS_HALO = 131072, LDS_PTAB = 139264, LDS_XB = 139264 + 512, LDS_BYTES = 147456;

__device__ __forceinline__ unsigned pk2(float lo, float hi) { return pg8::cvt_pk_bf16(lo, hi); }
__device__ __forceinline__ float wave_sum(float v) {
#pragma unroll
    for (int o = 1; o < 64; o <<= 1) v += __shfl_xor(v, o);
    return v;
}
__device__ __forceinline__ int perm_up(int n) { const int half = n >= DFF ? 1 : 0, ch = n - half * DFF; return (ch >> 7) * 256 + half * 128 + (ch & 127); }
template <int MODE> __device__ __forceinline__ void tr_item(const float* W, int K, int N, bf16_t* WT, LAS float* scr, int item, int lane) {
    const int nblk = (N + 31) / 32, kb = item / nblk, nb = item % nblk, k0 = 64 * kb, n0 = 32 * nb;
    const int nn = n0 + (lane & 31); const bool ok = nn < N;
#pragma unroll 8
    for (int i = 0; i < 32; ++i) { const int kk = 2 * i + (lane >> 5); scr[kk * 33 + (lane & 31)] = ok ? W[(size_t)(k0 + kk) * N + nn] : 0.f; }
    asm volatile("s_waitcnt lgkmcnt(0)" ::: "memory");
    const int c = lane & 7;
#pragma unroll
    for (int j = 0; j < 4; ++j) { const int n = (lane >> 3) + 8 * j; const LAS float* s = scr + (8 * c) * 33 + n;
        u32x4 o; o.x = pk2(s[0 * 33], s[1 * 33]); o.y = pk2(s[2 * 33], s[3 * 33]); o.z = pk2(s[4 * 33], s[5 * 33]); o.w = pk2(s[6 * 33], s[7 * 33]);
        const int ng = n0 + n; if (ng < N) { const int dr = MODE == 1 ? perm_up(ng) : ng; *(u32x4*)(WT + (size_t)dr * K + k0 + 8 * c) = o; } }
    asm volatile("s_waitcnt lgkmcnt(0)" ::: "memory");
}
__device__ __forceinline__ float log_sigmoid(float x) { return fminf(x, 0.f) - log1pf(expf(-fabsf(x))); }

#define XB_TMO      128
#define XB_XCNT(j)  (256  + 64 * (j))
#define XB_XSUB(j)  (1280 + 64 * (j))
#define XB_XGEN(j)  (2304 + 64 * (j))
#define XB_TOP      3328
#define XB_TOPGEN   3392
#define XCD_BAR_WORDS 3456
#define XB_SPIN_CAP (1u << 18)

__device__ __forceinline__ unsigned xb_ld(unsigned* p)              { return __hip_atomic_load(p, __ATOMIC_RELAXED, __HIP_MEMORY_SCOPE_AGENT); }
__device__ __forceinline__ unsigned xb_add(unsigned* p, unsigned v) { return __hip_atomic_fetch_add(p, v, __ATOMIC_RELAXED, __HIP_MEMORY_SCOPE_AGENT); }
__device__ __forceinline__ unsigned xb_xcc_id() { return (unsigned)__builtin_amdgcn_s_getreg((3 << 11) | 20) & 0xFu; }
#define XB_SPIN(cond, bar) do { unsigned _sp = 0; while (cond) { __builtin_amdgcn_s_sleep(1); \
    if ((++_sp & 255u) == 0u) { if (xb_ld(&(bar)[XB_TMO])) break; if (_sp > XB_SPIN_CAP) { atomicAdd(&(bar)[XB_TMO], 1u); break; } } } } while (0)

struct XcdBarrier {
    unsigned* bar; unsigned x;
    volatile LAS unsigned* st;
};

__device__ __forceinline__ XcdBarrier xcd_barrier_post(unsigned* bar, volatile LAS unsigned* st) {
    XcdBarrier b; b.bar = bar; b.x = xb_xcc_id(); b.st = st;
    if (threadIdx.x == 0) (void)xb_add(&bar[XB_XCNT(b.x)], 1u);
    return b;
}
__device__ __forceinline__ void xcd_barrier_complete(unsigned* bar, unsigned x, unsigned& nloc, unsigned& nx) {
    const unsigned G = gridDim.x * gridDim.y * gridDim.z;
    unsigned sum, cnt, mine, sp = 0u;
    for (;;) {
        sum = 0u; cnt = 0u; mine = 0u;
#pragma unroll
        for (unsigned j = 0; j < 16; ++j) { const unsigned c = xb_ld(&bar[XB_XCNT(j)]); sum += c; cnt += (c > 0u) ? 1u : 0u; mine = (j == x) ? c : mine; }
        if (sum == G) break;
        __builtin_amdgcn_s_sleep(1);
        if ((++sp & 255u) == 0u) { if (xb_ld(&bar[XB_TMO])) break; if (sp > XB_SPIN_CAP) { atomicAdd(&bar[XB_TMO], 1u); break; } }
    }
    nloc = mine > 0u ? mine : 1u; nx = cnt > 0u ? cnt : 1u;
}

__device__ __forceinline__ void xcd_barrier(const XcdBarrier& b) {
    asm volatile("s_waitcnt vmcnt(0)" ::: "memory");
    __syncthreads();
    if (threadIdx.x == 0) {
        unsigned* bar = b.bar;
        __builtin_amdgcn_s_waitcnt(0);
        unsigned nloc = b.st[0], nx = b.st[1];
        if (nloc == 0u) { xcd_barrier_complete(bar, b.x, nloc, nx); b.st[0] = nloc; b.st[1] = nx; }
        const unsigned old = xb_add(&bar[XB_XSUB(b.x)], 1u);
        const unsigned gen = old / nloc;
        if (old + 1u == (gen + 1u) * nloc) {
            __builtin_amdgcn_fence(__ATOMIC_RELEASE, "agent");
            asm volatile("s_waitcnt vmcnt(0)" ::: "memory");
            const unsigned og = xb_add(&bar[XB_TOP], 1u);
            const unsigned tg = og / nx;
            if (og + 1u == (tg + 1u) * nx) xb_add(&bar[XB_TOPGEN], 1u);
            else XB_SPIN(xb_ld(&bar[XB_TOPGEN]) == tg, bar);
            __builtin_amdgcn_fence(__ATOMIC_ACQUIRE, "agent");
            xb_add(&bar[XB_XGEN(b.x)], 1u);
            asm volatile("s_waitcnt vmcnt(0)" ::: "memory");
        } else {
            XB_SPIN(xb_ld(&bar[XB_XGEN(b.x)]) == gen, bar);
            __builtin_amdgcn_fence(__ATOMIC_ACQUIRE, "agent");
            asm volatile("s_waitcnt vmcnt(0)" ::: "memory");
        }
    }
    __syncthreads();
}

#ifndef PH
#define PH 0xFFFF
#endif
#define ON(k) ((PH >> (k)) & 1)
struct Args { const void* in[19]; float* out; unsigned char* ws; };
__device__ __forceinline__ const void* ldp(LAS unsigned long long* ptab, int i) { const unsigned long long v = ptab[i];
    const unsigned lo = __builtin_amdgcn_readfirstlane((unsigned)v), hi = __builtin_amdgcn_readfirstlane((unsigned)(v >> 32)); return (const void*)(const __attribute__((address_space(1))) void*)(((unsigned long long)hi << 32) | lo); }

__global__ void __launch_bounds__(512, 2) fwd_kernel(Args a) {
    extern __shared__ __attribute__((aligned(16))) unsigned char lds[];
    cg::grid_group grid = cg::this_grid();
#define tid (opaque_tid())
#define lane (opaque_tid() & 63)
#define wid (__builtin_amdgcn_readfirstlane(opaque_tid() >> 6))
    constexpr int G = 256, NGW = G * 8;
#define bid ((int)blockIdx.x)
#define vcu ((bid % 8) * (G / 8) + bid / 8)
#define gw (bid * 8 + wid)
    LAS unsigned long long* ptab = (LAS unsigned long long*)(lds + LDS_PTAB);
    if (tid < 19) ptab[tid] = (unsigned long long)a.in[tid];
    if (tid == 19) ptab[19] = (unsigned long long)a.out;
    if (tid == 20) ptab[20] = (unsigned long long)a.ws;
    if (tid == 21) { ((LAS unsigned*)(lds + LDS_XB))[0] = 0u; ((LAS unsigned*)(lds + LDS_XB))[1] = 0u; }
    __syncthreads();
    (void)xcd_barrier_post((unsigned*)a.ws, (volatile LAS unsigned*)(lds + LDS_XB));
#define GBAR() do { XcdBarrier b_; b_.bar = (unsigned*)WSP; b_.x = xb_xcc_id(); b_.st = (volatile LAS unsigned*)(lds + LDS_XB); xcd_barrier(b_); } while (0)
#define LDP(i) ldp(ptab, (i))
#define x_in ((const float*)LDP(0))
#define c_in ((const float*)LDP(1))
#define pos_in ((const int*)LDP(2))
#define fox_w_in ((const float*)LDP(3))
#define fox_b_f ((const float*)LDP(4))
#define fox_w_o ((const float*)LDP(5))
#define swa_w_in ((const float*)LDP(6))
#define swa_sinks ((const float*)LDP(7))
#define swa_w_o ((const float*)LDP(8))
#define ada_w ((const float*)LDP(9))
#define ada_b ((const float*)LDP(10))
#define ffn_w_up ((const float*)LDP(11))
#define ffn_conv_w ((const float*)LDP(12))
#define ffn_conv_b ((const float*)LDP(13))
#define ffn_w_down ((const float*)LDP(14))
#define ln_mix_g ((const float*)LDP(15))
#define ln_mix_b ((const float*)LDP(16))
#define ln_ffn_g ((const float*)LDP(17))
#define ln_ffn_b ((const float*)LDP(18))
#define xcur ((float*)LDP(19))
#define WSP ((unsigned char*)LDP(20))
#define mod ((float*)(WSP + WS_MOD))
#define rope ((float*)(WSP + WS_ROPE))
#define logf_ ((float*)(WSP + WS_LOGF))
#define ubuf ((float*)(WSP + WS_UBUF))
#define Wfin ((bf16_t*)(WSP + WS_WFIN))
#define Wfo ((bf16_t*)(WSP + WS_WFO))
#define Wsin ((bf16_t*)(WSP + WS_WSIN))
#define Wso ((bf16_t*)(WSP + WS_WSO))
#define Wup ((bf16_t*)(WSP + WS_WUP))
#define Wdn ((bf16_t*)(WSP + WS_WDN))
#define Hb ((bf16_t*)(WSP + WS_H))
#define Zb ((float*)(WSP + WS_Z))
#define Qb ((bf16_t*)(WSP + WS_Q))
#define Kb ((bf16_t*)(WSP + WS_K))
#define Vb ((bf16_t*)(WSP + WS_V))
#define Ob ((bf16_t*)(WSP + WS_O))
#define Actb Qb

    if (ON(0)) {
        const int i = bid * 512 + tid;
        float* rope_ = rope; const int* pos_ = pos_in;
        if (i < M * 8) { const int m = i >> 3, f = i & 7; const float inv = (float)pow(500000.0, -(double)f / 8.0); const float ang = (float)pos_[m] * inv;
            rope_[m * 16 + f] = (float)cos((double)ang); rope_[m * 16 + 8 + f] = (float)sin((double)ang); }
    }
    if (ON(1) && bid < 192) {
        LAS float* sc = (LAS float*)lds; LAS float* red = (LAS float*)(lds + 65536);
        const float* cin_ = c_in; const float* adaw_ = ada_w; const float* adab_ = ada_b; float* mod_ = mod;
        for (int i = tid; i < NB * DM; i += 512) { const int b = i >> 11, k = i & 2047; const float v = cin_[i]; sc[k * 8 + b] = v / (1.f + expf(-v)); }
        __syncthreads();
        const int l = bid / 96, n0 = (bid % 96) * 128, kq = tid >> 5, cl = tid & 31;
        const float* W = adaw_ + (size_t)l * DM * 12288 + n0 + 4 * cl;
        f32x4 acc[8];
#pragma unroll
        for (int b = 0; b < 8; ++b) acc[b] = (f32x4){0.f, 0.f, 0.f, 0.f};
#pragma unroll 4
        for (int kk = 0; kk < 128; ++kk) { const int k = kq + 16 * kk; const f32x4 w = *(const f32x4*)(W + (size_t)k * 12288);
            const f32x4 s0 = *(const LAS f32x4*)(sc + k * 8), s1 = *(const LAS f32x4*)(sc + k * 8 + 4);
            acc[0] += w * s0[0]; acc[1] += w * s0[1]; acc[2] += w * s0[2]; acc[3] += w * s0[3]; acc[4] += w * s1[0]; acc[5] += w * s1[1]; acc[6] += w * s1[2]; acc[7] += w * s1[3]; }
#pragma unroll
        for (int b = 0; b < 8; ++b) *(LAS f32x4*)(red + (kq * 8 + b) * 128 + 4 * cl) = acc[b];
        __syncthreads();
        for (int o = tid; o < 1024; o += 512) { const int b = o >> 7, col = o & 127; float s = 0.f;
#pragma unroll
            for (int q = 0; q < 16; ++q) s += red[(q * 8 + b) * 128 + col];
            mod_[(size_t)(l * 8 + b) * 12288 + n0 + col] = s + adab_[l * 12288 + n0 + col]; }
        __syncthreads();
    }
    if (ON(2)) {
        LAS float* scr = (LAS float*)(lds + wid * 16384);
        const float* p_fin = fox_w_in; const float* p_fo = fox_w_o; const float* p_sin = swa_w_in; const float* p_so = swa_w_o; const float* p_up = ffn_w_up; const float* p_dn = ffn_w_down; unsigned char* wsl = WSP;
        constexpr int I_FIN = 32 * 193, I_SQ = 32 * 64, I_SIN = 32 * 80, I_UP = 32 * 352, I_DN = 88 * 64;
        constexpr int NITEMS = I_FIN + 2 * I_SQ + I_SIN + 2 * I_UP + 2 * I_DN;
        for (int it = gw; it < NITEMS; it += NGW) {
            int r = it;
            if (r < I_FIN) { tr_item<0>(p_fin, DM, NFIN, (bf16_t*)(wsl + WS_WFIN), scr, r, lane); continue; } r -= I_FIN;
            if (r < I_SQ) { tr_item<0>(p_fo, DM, DM, (bf16_t*)(wsl + WS_WFO), scr, r, lane); continue; } r -= I_SQ;
            if (r < I_SIN) { tr_item<0>(p_sin, DM, NSIN, (bf16_t*)(wsl + WS_WSIN), scr, r, lane); continue; } r -= I_SIN;
            if (r < I_SQ) { tr_item<0>(p_so, DM, DM, (bf16_t*)(wsl + WS_WSO), scr, r, lane); continue; } r -= I_SQ;
            if (r < 2 * I_UP) { const int l = r / I_UP; tr_item<1>(p_up + (size_t)l * DM * 2 * DFF, DM, 2 * DFF, (bf16_t*)(wsl + WS_WUP) + (size_t)l * 2 * DFF * DM, scr, r - l * I_UP, lane); continue; } r -= 2 * I_UP;
            { const int l = r / I_DN; tr_item<0>(p_dn + (size_t)l * DFF * DM, DFF, DM, (bf16_t*)(wsl + WS_WDN) + (size_t)l * DM * DFF, scr, r - l * I_DN, lane); }
        }
    }
    grid.sync();

    for (int l = 0; l < 2; ++l) {
#define modl (mod + (size_t)l * 8 * 12288)
        if (ON(3) && l == 0) {
            const float* xin_ = x_in; const float* mod0_ = modl; bf16_t* hb_ = Hb;
            for (int m = gw; m < M; m += NGW) { const float* sh = mod0_ + (size_t)(m >> 11) * 12288; const float* scv = sh + 2048;
                const f32x4* xr = (const f32x4*)(xin_ + (size_t)m * DM) + lane; u32x2* ho = (u32x2*)(hb_ + (size_t)m * DM) + lane;
#pragma unroll
                for (int j = 0; j < 8; ++j) { const f32x4 v = xr[64 * j], s = *((const f32x4*)scv + lane + 64 * j), t = *((const f32x4*)sh + lane + 64 * j);
                    const f32x4 h = v * (s + 1.0f) + t; u32x2 w; w.x = pk2(h[0], h[1]); w.y = pk2(h[2], h[3]); ho[64 * j] = w; } }
            GBAR();
        }
        if (l == 0) {
            if (ON(4) && wid < 4) { const int m0 = (bid * 4 + wid) * 16; const bf16_t* hb_ = Hb; const bf16_t* wf_ = Wfin; const float* bfp_ = fox_b_f; float* lfo_ = logf_;
                if (m0 < M) { const bf16_t* ap = hb_ + (size_t)(m0 + (lane & 15)) * DM + 8 * (lane >> 4); const bf16_t* bp = wf_ + (size_t)(6144 + (lane & 15)) * DM + 8 * (lane >> 4);
                    f32x4 c0 = {0.f, 0.f, 0.f, 0.f}, c1 = c0, c2 = c0, c3 = c0;
#pragma unroll 2
                    for (int kk = 0; kk < 64; kk += 4) {
                        c0 = __builtin_amdgcn_mfma_f32_16x16x32_bf16(*(const bf16x8*)(ap + kk * 32), *(const bf16x8*)(bp + kk * 32), c0, 0, 0, 0);
                        c1 = __builtin_amdgcn_mfma_f32_16x16x32_bf16(*(const bf16x8*)(ap + kk * 32 + 32), *(const bf16x8*)(bp + kk * 32 + 32), c1, 0, 0, 0);
                        c2 = __builtin_amdgcn_mfma_f32_16x16x32_bf16(*(const bf16x8*)(ap + kk * 32 + 64), *(const bf16x8*)(bp + kk * 32 + 64), c2, 0, 0, 0);
                        c3 = __builtin_amdgcn_mfma_f32_16x16x32_bf16(*(const bf16x8*)(ap + kk * 32 + 96), *(const bf16x8*)(bp + kk * 32 + 96), c3, 0, 0, 0); }
                    const f32x4 cs = (c0 + c1) + (c2 + c3); const float bf = bfp_[lane & 15];
#pragma unroll
                    for (int r = 0; r < 4; ++r) lfo_[(size_t)(m0 + (lane >> 4) * 4 + r) * 16 + (lane & 15)] = log_sigmoid(cs[r] + bf); } }
            if (ON(5)) { pg8::Gemm g{Hb, Wfin, M, 6144, DM}; pg8::StaticOrder S; S.init(M, 6144, G, bid);
              pg8::EpiBf16 E{Qb, DM, DM, (size_t)(WS_K - WS_Q) / 2};
              pg8::gemm_phase<pg8::EpiBf16, pg8::StaticOrder, true, true>((LAS unsigned char*)lds, g, S, E); }
            GBAR();
            if (ON(6)) {
                fox::Seam S;
                auto mk = [](int j, int vcu_, const bf16_t* Q, const bf16_t* K, const bf16_t* V, bf16_t* O, const float* lf) {
                    const int item = vcu_ + 256 * (j >> 1), bh = item >> 2, xq = item & 3, qb = (j & 1) ? 7 - xq : xq, b = bh >> 4, h = bh & 15;
                    fox::BlockRef r; const size_t ro = (size_t)(b * SEQ) * DM + h * 128;
                    r.Q = Q + ro + (size_t)(qb * 256) * DM; r.K = K + ro; r.V = V + ro; r.O = O + ro + (size_t)(qb * 256) * DM; r.lf = lf + (size_t)(b * SEQ) * 16 + h; r.P0 = qb * 256; return r; };
                { const float* lfp_ = logf_;
                  for (int j = 0; j < 4; ++j) { const fox::BlockRef r = mk(j, vcu, nullptr, nullptr, nullptr, nullptr, lfp_); fox::key_bias(r, (char*)lds, j); } }
                int vc2 = vcu; asm volatile("" : "+s"(vc2));
                const bf16_t* q_ = Qb; const bf16_t* k_ = Kb; const bf16_t* v_ = Vb; bf16_t* o_ = Ob;
                fox::BlockRef cur = mk(0, vc2, q_, k_, v_, o_, nullptr);
                fox::prime(cur, (char*)lds, S);
                for (int j = 0; j < 4; ++j) { const fox::BlockRef nxt = (j < 3) ? mk(j + 1, vc2, q_, k_, v_, o_, nullptr) : cur;
                    fox::block(cur, nxt, (char*)lds, S, j); cur = nxt; }
            }
            GBAR();
        } else {
            if (ON(7)) { pg8::Gemm g{Hb, Wsin, M, NSIN, DM}; pg8::StaticOrder S; S.init(M, NSIN, G, bid);
              pg8::EpiBf16 E{Qb, NSIN, 0, 0};
              pg8::gemm_phase<pg8::EpiBf16, pg8::StaticOrder, true, true>((LAS unsigned char*)lds, g, S, E); }
            GBAR();
            if (ON(8)) { const bf16_t* qkv_ = Qb; bf16_t* o_ = Ob; const float* rp_ = rope; const float* sk_ = swa_sinks;
              for (int u = vcu; u < 512; u += G) { const int hk = u & 3, n = (u >> 2) & 15, b = u >> 6; swa::unit(b, n, hk, qkv_, o_, rp_, sk_, (char*)lds); } }
            GBAR();
        }
        if (ON(9)) { pg8::Gemm g{Ob, l == 0 ? Wfo : Wso, M, DM, DM}; pg8::StaticOrder S; S.init(M, DM, G, bid);
          pg8::EpiZ E{l == 0 ? x_in : xcur, Zb, modl + 2 * 2048, ALPHA};
          pg8::gemm_phase<pg8::EpiZ, pg8::StaticOrder, true, true>((LAS unsigned char*)lds, g, S, E); }
        GBAR();
#define LN_PHASE(GV, BV, SHV, SCV, WRITE_H) do { const float* zb_ = Zb; float* xc_ = xcur; bf16_t* hb_ = Hb; const float* gv_ = (GV); const float* bv_ = (BV); const float* shv_ = (SHV); const float* scv_ = (SCV); \
        for (int m = gw; m < M; m += NGW) { const f32x4* zr = (const f32x4*)(zb_ + (size_t)m * DM) + lane; f32x4 v[8]; float s = 0.f; \
            _Pragma("unroll") for (int j = 0; j < 8; ++j) { v[j] = zr[64 * j]; s += (v[j][0] + v[j][1]) + (v[j][2] + v[j][3]); } \
            const float mean = wave_sum(s) * (1.f / DM); float s2 = 0.f; \
            _Pragma("unroll") for (int j = 0; j < 8; ++j) { v[j] = v[j] - mean; s2 += (v[j][0] * v[j][0] + v[j][1] * v[j][1]) + (v[j][2] * v[j][2] + v[j][3] * v[j][3]); } \
            const float rstd = 1.f / sqrtf(wave_sum(s2) * (1.f / DM) + LN_EPS); \
            f32x4* xo = (f32x4*)(xc_ + (size_t)m * DM) + lane; u32x2* ho = (u32x2*)(hb_ + (size_t)m * DM) + lane; \
            const float* shp = shv_ + (size_t)(m >> 11) * 12288; const float* scp = scv_ + (size_t)(m >> 11) * 12288; \
            _Pragma("unroll") for (int j = 0; j < 8; ++j) { const f32x4 gg = *((const f32x4*)gv_ + lane + 64 * j), bb = *((const f32x4*)bv_ + lane + 64 * j); \
                const f32x4 y = v[j] * rstd * gg + bb; xo[64 * j] = y; \
                if (WRITE_H) { const f32x4 sv = *((const f32x4*)scp + lane + 64 * j), tv = *((const f32x4*)shp + lane + 64 * j); const f32x4 h = y * (sv + 1.0f) + tv; \
                    u32x2 w; w.x = pk2(h[0], h[1]); w.y = pk2(h[2], h[3]); ho[64 * j] = w; } } } } while (0)
        if (ON(10)) LN_PHASE(ln_mix_g + l * DM, ln_mix_b + l * DM, modl + 3 * 2048, modl + 4 * 2048, true);
        GBAR();
        if (ON(11)) { pg8::Gemm g{Hb, Wup + (size_t)l * 2 * DFF * DM, M, 2 * DFF, DM}; pg8::StaticOrder S; S.init(M, 2 * DFF, G, bid);
          pg8::EpiUp E{Actb, ubuf, ffn_conv_w + (size_t)l * 3 * 2 * DFF, ffn_conv_b + (size_t)l * 2 * DFF, (LAS unsigned char*)lds + LDS_HALO};
          pg8::gemm_phase<pg8::EpiUp, pg8::StaticOrder, true, true>((LAS unsigned char*)lds, g, S, E); }
        GBAR();
        if (ON(12)) {
            const float* cw = ffn_conv_w + (size_t)l * 3 * 2 * DFF; const float* cb = ffn_conv_b + (size_t)l * 2 * DFF; const float* ub_ = ubuf; bf16_t* act_ = Actb;
            for (int i = bid * 512 + tid; i < 64 * 2 * (DFF / 4); i += G * 512) { const int pm = i / (2 * (DFF / 4)), rem = i % (2 * (DFF / 4)), r = rem / (DFF / 4), c4 = (rem % (DFF / 4)) * 4;
                if ((pm & 7) == 0) continue;
                f32x4 y[2];
#pragma unroll
                for (int hf = 0; hf < 2; ++hf) { const float* up = ub_ + ((size_t)((pm - 1) * 4) * 2 + hf) * DFF + c4; const float* uc = ub_ + ((size_t)(pm * 4) * 2 + hf) * DFF + c4;
                    const f32x4 um2 = *(const f32x4*)(up + (size_t)2 * 2 * DFF), um1 = *(const f32x4*)(up + (size_t)3 * 2 * DFF), u0 = *(const f32x4*)(uc), u1 = *(const f32x4*)(uc + (size_t)2 * DFF);
                    const int ci = hf * DFF + c4; const f32x4 w0 = *(const f32x4*)(cw + ci), w1 = *(const f32x4*)(cw + 2 * DFF + ci), w2 = *(const f32x4*)(cw + 4 * DFF + ci), b4 = *(const f32x4*)(cb + ci);
                    y[hf] = (r == 0) ? (w0 * um2 + w1 * um1 + w2 * u0 + b4) : (w0 * um1 + w1 * u0 + w2 * u1 + b4); }
                float o[4];
#pragma unroll
                for (int e = 0; e < 4; ++e) { const float gq = y[0][e]; o[e] = gq / (1.f + expf(-gq)) * y[1][e]; }
                u32x2 w; w.x = pk2(o[0], o[1]); w.y = pk2(o[2], o[3]); *(u32x2*)(act_ + (size_t)(pm * 256 + r) * DFF + c4) = w; }
        }
        GBAR();
        if (ON(13)) { pg8::Gemm g{Actb, Wdn + (size_t)l * DM * DFF, M, DM, DFF}; pg8::StaticOrder S; S.init(M, DM, G, bid);
          pg8::EpiZ E{xcur, Zb, modl + 5 * 2048, ALPHA};
          pg8::gemm_phase<pg8::EpiZ, pg8::StaticOrder, true, true>((LAS unsigned char*)lds, g, S, E); }
        GBAR();
        if (!ON(14)) {} else if (l == 0) { LN_PHASE(ln_ffn_g, ln_ffn_b, mod + (size_t)8 * 12288, mod + (size_t)8 * 12288 + 2048, true); GBAR(); }
        else { LN_PHASE(ln_ffn_g + DM, ln_ffn_b + DM, mod, mod, false); }
    }
}

extern "C" void kernel_launch(void* const* d_in, const int* in_sizes, int n_in, void* d_out, int out_size, void* d_ws, size_t ws_size, hipStream_t stream) {
    static int grid = 0;
    if (grid == 0) {
        if (n_in != 19 || out_size != M * DM || ws_size < WS_END) { fprintf(stderr, "kernel_launch: unexpected shapes (n_in %d out %d ws %zu)\n", n_in, out_size, ws_size); grid = -1; return; }
        int dev = 0, cus = 0, per_cu = 0;
        (void)hipGetDevice(&dev); (void)hipDeviceGetAttribute(&cus, hipDeviceAttributeMultiprocessorCount, dev);
        if (hipFuncSetAttribute((const void*)fwd_kernel, hipFuncAttributeMaxDynamicSharedMemorySize, LDS_BYTES) != hipSuccess) { fprintf(stderr, "kernel_launch: hipFuncSetAttribute failed\n"); grid = -1; return; }
        if (hipOccupancyMaxActiveBlocksPerMultiprocessor(&per_cu, (const void*)fwd_kernel, 512, LDS_BYTES) != hipSuccess || per_cu < 1) { fprintf(stderr, "kernel_launch: occupancy query says %d\n", per_cu); per_cu = 1; }
        (void)hipGetLastError();
        if (cus != 256) fprintf(stderr, "kernel_launch: %d CUs (built for 256)\n", cus);
        grid = 256;
    }
    if (grid < 0) return;
    if (hipMemsetAsync(d_ws, 0, 16384, stream) != hipSuccess) { fprintf(stderr, "kernel_launch: memset failed\n"); return; }
    Args a{};
    for (int i = 0; i < 19; ++i) a.in[i] = d_in[i];
    a.out = (float*)d_out; a.ws = (unsigned char*)d_ws;
    void* params[] = {&a};
    const hipError_t e = hipLaunchCooperativeKernel((const void*)fwd_kernel, dim3(grid), dim3(512), params, LDS_BYTES, stream);
    if (e != hipSuccess) fprintf(stderr, "kernel_launch: cooperative launch failed: %s\n", hipGetErrorString(e));
}
```

```cpp
#include <hip/hip_runtime.h>
#include <hip/hip_cooperative_groups.h>
#include <cstdio>
#include <cstdint>
#include <cmath>
namespace cg = cooperative_groups;
typedef __attribute__((address_space(3))) unsigned long long* ptab_t;
__device__ __forceinline__ const void* ldp(ptab_t ptab, int i) { const unsigned long long v = ptab[i];
    const unsigned lo = __builtin_amdgcn_readfirstlane((unsigned)v), hi = __builtin_amdgcn_readfirstlane((unsigned)(v >> 32)); return (const void*)(const __attribute__((address_space(1))) void*)(((unsigned long long)hi << 32) | lo); }
constexpr size_t WSO_MOD = (size_t)1 << 20, WSO_STATS = ((size_t)1 << 20) + 786432, WSO_Z = (size_t)264 << 20, WSO_UBUF = (size_t)4 << 20, WSO_Q = (size_t)392 << 20;
__device__ __forceinline__ int opaque_tid() { int t = threadIdx.x; asm volatile("" : "+v"(t)); return t & 511; }
namespace pg8 {
#define PG8_LAS __attribute__((address_space(3)))
typedef unsigned short bf16_t;
typedef short bf16x8 __attribute__((ext_vector_type(8)));
typedef float f32x4 __attribute__((ext_vector_type(4)));
typedef unsigned u32x4 __attribute__((ext_vector_type(4)));
typedef unsigned u32x2 __attribute__((ext_vector_type(2)));
constexpr int BM = 256, BK = 64, HALF = 128, HTB = HALF * BK * 2  , STAGE_BYTES = 8 * HTB, NXCD = 8, WGM = 8;

__host__ __device__ __forceinline__ int lds_byte(int r, int c) { const int st = (r >> 4) * 2 + (c >> 5), rr = r & 15, cc = c & 31, ob = rr * 64 + cc * 2; return st * 1024 + (ob ^ (((ob >> 9) & 1) << 5)); }
__host__ __device__ __forceinline__ void stage_rc(int b, int& R, int& C) { const int st = b / 1024, sb = b % 1024, swz = sb ^ (((sb >> 9) & 1) << 5); R = (st >> 1) * 16 + swz / 64; C = (st & 1) * 32 + (swz % 64) / 2; }
__host__ __device__ __forceinline__ int perm32(int rho) { const int n = rho >> 4, i = rho & 15; return 8 * (i >> 2) + 4 * n + (i & 3); }

struct Unit { int pm, pn; };
struct Gemm { const bf16_t* A; const bf16_t* Bt; int M, N, K; };

struct StaticOrder {
    int nM, nN, nwg, G, c;
    __host__ __device__ void init(int M, int N, int G_, int c_) { nM = M / BM; nN = N / BM; nwg = nM * nN; G = G_; c = c_; }
    __host__ __device__ bool next(int i, Unit& u) const {
        const long L = (long)i * G + c; if (L >= nwg) return false;
        int wgid = (int)L; { const int q = nwg / NXCD, r = nwg % NXCD, xcd = wgid % NXCD, off = wgid / NXCD; wgid = (xcd < r ? xcd * (q + 1) : r * (q + 1) + (xcd - r) * q) + off; }
        const int nig = WGM * nN, gid = wgid / nig, fm = gid * WGM, gsz = (nM - fm) < WGM ? (nM - fm) : WGM;
        u.pm = fm + ((wgid % nig) % gsz); u.pn = (wgid % nig) / gsz; return true;
    }
    __device__ __forceinline__ void a_ready(const Unit&) const {}
    __device__ __forceinline__ void done(const Unit&) const {}
};

__device__ __forceinline__ unsigned cvt_pk_bf16(float lo, float hi) { unsigned r; asm volatile("v_cvt_pk_bf16_f32 %0, %1, %2" : "=v"(r) : "v"(lo), "v"(hi)); return r; }
struct EpiBf16 {
    static constexpr bool PERM = true, AFTER_DRAIN = false;
    ptab_t ptab; int ldc; int split_cols; size_t split_stride;
    __device__ __forceinline__ void operator()(const f32x4 (&acc)[2][2][4][2], const Unit& u, int wr, int wc, int fr, int fq) const {
        bf16_t* O = (bf16_t*)((unsigned char*)ldp(ptab, 20) + WSO_Q);
        const int row0 = u.pm * BM + wr * 64 + fr; int colt = u.pn * BM; bf16_t* base = O;
        if (split_cols) { const int t = colt / split_cols; base += (size_t)t * split_stride; colt -= t * split_cols; }
        const int col0 = colt + wc * 32 + 8 * fq;
#pragma unroll
        for (int ai = 0; ai < 2; ++ai)
#pragma unroll
            for (int m = 0; m < 4; ++m) { bf16_t* rowp = base + (size_t)(row0 + ai * HALF + m * 16) * ldc + col0;
#pragma unroll
                for (int bj = 0; bj < 2; ++bj) { const f32x4 v0 = acc[ai][bj][m][0], v1 = acc[ai][bj][m][1];
                    u32x4 w; w.x = cvt_pk_bf16(v0[0], v0[1]); w.y = cvt_pk_bf16(v0[2], v0[3]); w.z = cvt_pk_bf16(v1[0], v1[1]); w.w = cvt_pk_bf16(v1[2], v1[3]);
                    *(u32x4*)(rowp + bj * HALF) = w; } }
    }
};
struct EpiZ {
    static constexpr bool PERM = false, AFTER_DRAIN = false;
    ptab_t ptab; int l, sub;
    __device__ __forceinline__ void operator()(const f32x4 (&acc)[2][2][4][2], const Unit& u, int wr, int wc, int fr, int fq) const {
        constexpr float alpha = 1.4142135623730951f;
        unsigned char* wsp = (unsigned char*)ldp(ptab, 20);
        float* z = (float*)(wsp + WSO_Z); const float* gate = (const float*)(wsp + WSO_MOD) + (size_t)l * 8 * 12288 + (sub ? 5 : 2) * 2048;
        const float* xres = (const float*)ldp(ptab, 0); const float* stats = (sub == 0 && l == 0) ? nullptr : (const float*)(wsp + WSO_STATS);
        const float* lg = sub ? (const float*)ldp(ptab, 15) + l * 2048 : (const float*)ldp(ptab, 17); const float* lb = sub ? (const float*)ldp(ptab, 16) + l * 2048 : (const float*)ldp(ptab, 18);
        const float* gv = gate + (size_t)(u.pm >> 3) * 12288;
        const int col0 = u.pn * BM + wc * 32 + 4 * fq;
        f32x4 g[2][2];
#pragma unroll
        for (int bj = 0; bj < 2; ++bj)
#pragma unroll
            for (int n = 0; n < 2; ++n) g[bj][n] = *(const f32x4*)(gv + col0 + bj * HALF + n * 16) + 1.0f;
        if (stats == nullptr) {
#pragma unroll
            for (int ai = 0; ai < 2; ++ai)
#pragma unroll
                for (int m = 0; m < 4; ++m) { const size_t off = (size_t)(u.pm * BM + ai * HALF + wr * 64 + m * 16 + fr) * 2048 + col0;
#pragma unroll
                    for (int bj = 0; bj < 2; ++bj)
#pragma unroll
                        for (int n = 0; n < 2; ++n) { const f32x4 xr = *(const f32x4*)(xres + off + bj * HALF + n * 16);
                            *(f32x4*)(z + off + bj * HALF + n * 16) = xr * alpha + g[bj][n] * acc[ai][bj][m][n]; }
                    asm volatile("" ::: "memory"); }
        } else {
            f32x4 wg[2][2], wb[2][2];
#pragma unroll
            for (int bj = 0; bj < 2; ++bj)
#pragma unroll
                for (int n = 0; n < 2; ++n) { wg[bj][n] = *(const f32x4*)(lg + col0 + bj * HALF + n * 16) * alpha; wb[bj][n] = *(const f32x4*)(lb + col0 + bj * HALF + n * 16) * alpha; }
#pragma unroll
            for (int ai = 0; ai < 2; ++ai)
#pragma unroll
                for (int m = 0; m < 4; ++m) { const int row = u.pm * BM + ai * HALF + wr * 64 + m * 16 + fr; const size_t off = (size_t)row * 2048 + col0;
                    const float mean = stats[2 * row], rstd = stats[2 * row + 1];
#pragma unroll
                    for (int bj = 0; bj < 2; ++bj)
#pragma unroll
                        for (int n = 0; n < 2; ++n) { const f32x4 zo = *(const f32x4*)(z + off + bj * HALF + n * 16);
                            *(f32x4*)(z + off + bj * HALF + n * 16) = ((zo - mean) * rstd) * wg[bj][n] + wb[bj][n] + g[bj][n] * acc[ai][bj][m][n]; }
                    asm volatile("" ::: "memory"); }
        }
    }
};
__device__ __forceinline__ float dpp_ror1(float v) { return __builtin_bit_cast(float, __builtin_amdgcn_update_dpp(0, __builtin_bit_cast(int, v), 0x121, 0xf, 0xf, false)); }
__device__ __forceinline__ float dpp_ror2(float v) { return __builtin_bit_cast(float, __builtin_amdgcn_update_dpp(0, __builtin_bit_cast(int, v), 0x122, 0xf, 0xf, false)); }
struct EpiUp {
    static constexpr bool PERM = true, AFTER_DRAIN = false;
    ptab_t ptab; int l; PG8_LAS unsigned char* halo;
    __device__ __forceinline__ void operator()(const f32x4 (&acc)[2][2][4][2], const Unit& u, int wr, int wc, int fr, int fq) const {
        unsigned char* wsp = (unsigned char*)ldp(ptab, 20);
        bf16_t* act = (bf16_t*)(wsp + WSO_Q); float* ubuf = (float*)(wsp + WSO_UBUF);
        const float* cw = (const float*)ldp(ptab, 12) + (size_t)l * 3 * 11264; const float* cb = (const float*)ldp(ptab, 13) + (size_t)l * 11264;
        const int tcol = wc * 32 + 8 * fq;
        const int ch0 = u.pn * 128 + tcol;
        if (fr >= 14) {
#pragma unroll
            for (int ai = 0; ai < 2; ++ai) { const int blk = 2 * ai + wr;
                if (blk < 3) {
#pragma unroll
                    for (int bj = 0; bj < 2; ++bj)
#pragma unroll
                        for (int n = 0; n < 2; ++n) *(PG8_LAS f32x4*)(halo + (size_t)(((blk * 2 + (fr - 14)) * 256) + bj * 128 + tcol + 4 * n) * 4) = acc[ai][bj][3][n];
                } }
            if (wr == 1) {
#pragma unroll
                for (int bj = 0; bj < 2; ++bj)
#pragma unroll
                    for (int n = 0; n < 2; ++n) *(f32x4*)(ubuf + ((size_t)((u.pm * 4 + 2 + (fr - 14)) * 2 + bj)) * 5632 + ch0 + 4 * n) = acc[1][bj][3][n];
            }
        }
        if (wr == 0 && fr < 2) {
#pragma unroll
            for (int bj = 0; bj < 2; ++bj)
#pragma unroll
                for (int n = 0; n < 2; ++n) *(f32x4*)(ubuf + ((size_t)((u.pm * 4 + fr) * 2 + bj)) * 5632 + ch0 + 4 * n) = acc[0][bj][0][n];
        }
        asm volatile("s_waitcnt lgkmcnt(0)" ::: "memory"); __builtin_amdgcn_s_barrier(); asm volatile("" ::: "memory");
        const bool f1 = fr >= 1, f2 = fr >= 2;
#pragma unroll
        for (int n = 0; n < 2; ++n) {
            f32x4 w0[2], w1[2], w2[2], bb[2];
#pragma unroll
            for (int bj = 0; bj < 2; ++bj) { const int ci = bj * 5632 + ch0 + 4 * n;
                w0[bj] = *(const f32x4*)(cw + ci); w1[bj] = *(const f32x4*)(cw + 11264 + ci); w2[bj] = *(const f32x4*)(cw + 22528 + ci); bb[bj] = *(const f32x4*)(cb + ci); }
#pragma unroll
            for (int ai = 0; ai < 2; ++ai) { const int blk = 2 * ai + wr;
                f32x4 H[2];
#pragma unroll
                for (int bj = 0; bj < 2; ++bj) { H[bj] = (f32x4){0.f, 0.f, 0.f, 0.f};
                    if (blk > 0 && fr >= 14) H[bj] = *(const PG8_LAS f32x4*)(halo + (size_t)((((blk - 1) * 2 + (fr - 14)) * 256) + bj * 128 + tcol + 4 * n) * 4); }
#pragma unroll
                for (int m = 0; m < 4; ++m) {
                    f32x4 y[2];
#pragma unroll
                    for (int bj = 0; bj < 2; ++bj) { const f32x4 cur = acc[ai][bj][m][n]; f32x4 prv; if (m == 0) prv = H[bj]; else prv = acc[ai][bj][m > 0 ? m - 1 : 0][n];
#pragma unroll
                        for (int e = 0; e < 4; ++e) { const float c1 = dpp_ror1(cur[e]), p1 = dpp_ror1(prv[e]), c2 = dpp_ror2(cur[e]), p2 = dpp_ror2(prv[e]);
                            const float a1 = f1 ? c1 : p1, a2 = f2 ? c2 : p2;
                            y[bj][e] = fmaf(w2[bj][e], cur[e], fmaf(w1[bj][e], a1, fmaf(w0[bj][e], a2, bb[bj][e]))); } }
                    float o[4];
#pragma unroll
                    for (int e = 0; e < 4; ++e) { const float g = y[0][e]; const float sg = g * __builtin_amdgcn_rcpf(1.0f + __builtin_amdgcn_exp2f(-1.4426950408889634f * g)); o[e] = sg * y[1][e]; }
                    u32x2 w; w.x = cvt_pk_bf16(o[0], o[1]); w.y = cvt_pk_bf16(o[2], o[3]);
                    *(u32x2*)(act + (size_t)(u.pm * BM + ai * HALF + wr * 64 + m * 16 + fr) * 5632 + ch0 + 4 * n) = w;
                }
            }
            asm volatile("" ::: "memory");
        }
    }
};
template <class Epi, class Sched, bool ALIGN_EPI = false, bool SP2 = false>
__device__ __forceinline__ void gemm_phase(PG8_LAS unsigned char* lds, const Gemm g, const Sched& S, const Epi& E) {
    const int tid = opaque_tid(), wid = __builtin_amdgcn_readfirstlane(tid >> 6), lane = tid & 63, wr = wid >> 2, wc = wid & 3, fr = lane & 15, fq = lane >> 4;
    const int K = g.K, nt = K / BK;
    unsigned voffA[2], voffB[2];
#pragma unroll
    for (int i = 0; i < 2; ++i) { int R, C; stage_rc(tid * 16 + i * 8192, R, C); const int Rb = Epi::PERM ? ((R & ~31) + perm32(R & 31)) : R;
        voffA[i] = (unsigned)(R * K + C) * 2u; voffB[i] = (unsigned)(Rb * K + C) * 2u; }
    const size_t kstep = (size_t)(BK * 2);
    const size_t hstep = (size_t)HALF * K * 2;
    const size_t tstep = 2 * hstep;
    const unsigned ldsw = (unsigned)wid * 1024u;
    const int aoff = lds_byte(wr * 64 + fr, fq * 8), boff = lds_byte(wc * 32 + fr, fq * 8);
#define PG8_SA(b, h) (((b) * 2 + (h)) * HTB)
#define PG8_SB(b, h) ((4 + (b) * 2 + (h)) * HTB)
#define PG8_STAGE(bufoff, gbase, voff) do { _Pragma("unroll") for (int _i = 0; _i < 2; ++_i) \
        __builtin_amdgcn_global_load_lds((const unsigned*)((const char*)(gbase) + (voff)[_i]), (PG8_LAS unsigned*)(lds + (bufoff) + ldsw + _i * 8192), 16, 0, 0); } while (0)
#define PG8_LDA(dst, b, h) do { _Pragma("unroll") for (int m = 0; m < 4; ++m) _Pragma("unroll") for (int k = 0; k < 2; ++k) dst[m][k] = *(const PG8_LAS bf16x8*)(lds + PG8_SA(b, h) + aoff + m * 2048 + k * 1024); } while (0)
#define PG8_LDB(dst, b, h) do { _Pragma("unroll") for (int n = 0; n < 2; ++n) _Pragma("unroll") for (int k = 0; k < 2; ++k) dst[n][k] = *(const PG8_LAS bf16x8*)(lds + PG8_SB(b, h) + boff + n * 2048 + k * 1024); } while (0)
#define PG8_MMA(ai, bj, At, Bt) do { __builtin_amdgcn_s_setprio(1); _Pragma("unroll") for (int m = 0; m < 4; ++m) _Pragma("unroll") for (int n = 0; n < 2; ++n) _Pragma("unroll") for (int k = 0; k < 2; ++k) \
        acc[ai][bj][m][n] = __builtin_amdgcn_mfma_f32_16x16x32_bf16(Bt[n][k], At[m][k], acc[ai][bj][m][n], 0, 0, 0); __builtin_amdgcn_s_setprio(0); } while (0)
#define PG8_WAIT_V(n) asm volatile("s_waitcnt vmcnt(" #n ")" ::: "memory")
#define PG8_WAIT_L(n) asm volatile("s_waitcnt lgkmcnt(" #n ")" ::: "memory")
#define PG8_BAR __builtin_amdgcn_s_barrier()
#define PG8_SCHED __builtin_amdgcn_sched_barrier(0)
    Unit cur, nxt; int ui = 0;
    if (!S.next(0, cur)) return;
    f32x4 acc[2][2][4][2];
#pragma unroll
    for (int a = 0; a < 2; ++a)
#pragma unroll
        for (int b = 0; b < 2; ++b)
#pragma unroll
            for (int m = 0; m < 4; ++m)
#pragma unroll
                for (int n = 0; n < 2; ++n) acc[a][b][m][n] = (f32x4){0.f, 0.f, 0.f, 0.f};
    bf16x8 At[4][2], B0[2][2], B1[2][2];
    const char* cA = (const char*)g.A + (size_t)cur.pm * tstep; const char* cB = (const char*)g.Bt + (size_t)cur.pn * tstep;
    S.a_ready(cur);
    if constexpr (SP2) {
        PG8_STAGE(PG8_SB(0, 0), cB, voffB); PG8_STAGE(PG8_SB(0, 1), cB + hstep, voffB); PG8_STAGE(PG8_SA(0, 0), cA, voffA); PG8_STAGE(PG8_SA(0, 1), cA + hstep, voffA);
        if (wr == 1) PG8_BAR;
        PG8_WAIT_V(2); PG8_BAR;
        PG8_STAGE(PG8_SB(1, 0), cB + kstep, voffB); PG8_STAGE(PG8_SA(1, 0), cA + kstep, voffA); PG8_STAGE(PG8_SB(1, 1), cB + hstep + kstep, voffB);
        PG8_WAIT_V(6); PG8_BAR;
    } else {
        PG8_STAGE(PG8_SB(0, 0), cB, voffB); PG8_STAGE(PG8_SA(0, 0), cA, voffA); PG8_STAGE(PG8_SB(0, 1), cB + hstep, voffB); PG8_STAGE(PG8_SA(0, 1), cA + hstep, voffA);
        if (wr == 1) PG8_BAR;
        PG8_WAIT_V(4); PG8_BAR;
        PG8_STAGE(PG8_SB(1, 0), cB + kstep, voffB); PG8_STAGE(PG8_SA(1, 0), cA + kstep, voffA); PG8_STAGE(PG8_SB(1, 1), cB + hstep + kstep, voffB);
        PG8_WAIT_V(6); PG8_BAR;
    }
    for (;;) {
        const bool has_next = S.next(ui + 1, nxt);
        const char* nA = has_next ? (const char*)g.A + (size_t)nxt.pm * tstep : cA; const char* nB = has_next ? (const char*)g.Bt + (size_t)nxt.pn * tstep : cB;
        for (int t = 0; t < nt; t += 2) {
            const bool last = (t == nt - 2);
            const char* a1 = cA + (size_t)(t + 1) * kstep;
            const char* a2 = last ? nA : cA + (size_t)(t + 2) * kstep; const char* b2 = last ? nB : cB + (size_t)(t + 2) * kstep;
            const char* a3 = a2 + kstep; const char* b3 = b2 + kstep;
            if (last && has_next) S.a_ready(nxt);
            if constexpr (SP2) {
            PG8_LDB(B0, 0, 0); PG8_LDB(B1, 0, 1); PG8_SCHED; PG8_LDA(At, 0, 0); PG8_STAGE(PG8_SA(1, 1), a1 + hstep, voffA);
            PG8_WAIT_V(8); PG8_WAIT_L(0); PG8_BAR; PG8_MMA(0, 0, At, B0); PG8_MMA(0, 1, At, B1); PG8_BAR; PG8_SCHED;
            PG8_LDA(At, 0, 1); PG8_STAGE(PG8_SB(0, 0), b2, voffB); PG8_STAGE(PG8_SB(0, 1), b2 + hstep, voffB); PG8_STAGE(PG8_SA(0, 0), a2, voffA);
            PG8_WAIT_V(8); PG8_WAIT_L(0); PG8_BAR; PG8_MMA(1, 0, At, B0); PG8_MMA(1, 1, At, B1); PG8_BAR; PG8_SCHED;
            PG8_LDB(B0, 1, 0); PG8_LDB(B1, 1, 1); PG8_SCHED; PG8_LDA(At, 1, 0); PG8_STAGE(PG8_SA(0, 1), a2 + hstep, voffA);
            PG8_WAIT_V(8); PG8_WAIT_L(0); PG8_BAR; PG8_MMA(0, 0, At, B0); PG8_MMA(0, 1, At, B1); PG8_BAR; PG8_SCHED;
            PG8_LDA(At, 1, 1); PG8_STAGE(PG8_SB(1, 0), b3, voffB); PG8_STAGE(PG8_SB(1, 1), b3 + hstep, voffB); PG8_STAGE(PG8_SA(1, 0), a3, voffA);
            PG8_WAIT_V(8); PG8_WAIT_L(0); PG8_BAR; PG8_MMA(1, 0, At, B0); PG8_MMA(1, 1, At, B1); PG8_BAR; PG8_SCHED;
            } else {
            PG8_LDB(B0, 0, 0); PG8_SCHED; PG8_LDA(At, 0, 0); PG8_STAGE(PG8_SA(1, 1), a1 + hstep, voffA);
            PG8_WAIT_L(8); PG8_BAR; PG8_WAIT_L(0); PG8_MMA(0, 0, At, B0); PG8_BAR; PG8_SCHED;
            PG8_LDB(B1, 0, 1); PG8_STAGE(PG8_SB(0, 0), b2, voffB);
            PG8_BAR; PG8_WAIT_L(0); PG8_MMA(0, 1, At, B1); PG8_BAR;
            PG8_LDA(At, 0, 1); PG8_STAGE(PG8_SA(0, 0), a2, voffA);
            PG8_BAR; PG8_WAIT_L(0); PG8_MMA(1, 0, At, B0); PG8_BAR; PG8_SCHED;
            PG8_STAGE(PG8_SB(0, 1), b2 + hstep, voffB);
            PG8_WAIT_V(6); PG8_BAR; PG8_MMA(1, 1, At, B1); PG8_BAR;
            PG8_LDB(B0, 1, 0); PG8_SCHED; PG8_LDA(At, 1, 0); PG8_STAGE(PG8_SA(0, 1), a2 + hstep, voffA);
            PG8_WAIT_L(8); PG8_BAR; PG8_WAIT_L(0); PG8_MMA(0, 0, At, B0); PG8_BAR; PG8_SCHED;
            PG8_LDB(B1, 1, 1); PG8_STAGE(PG8_SB(1, 0), b3, voffB);
            PG8_BAR; PG8_WAIT_L(0); PG8_MMA(0, 1, At, B1); PG8_BAR;
            PG8_LDA(At, 1, 1); PG8_STAGE(PG8_SA(1, 0), a3, voffA);
            PG8_BAR; PG8_WAIT_L(0); PG8_MMA(1, 0, At, B0); PG8_BAR; PG8_SCHED;
            PG8_STAGE(PG8_SB(1, 1), b3 + hstep, voffB);
            PG8_WAIT_V(6); PG8_BAR; PG8_MMA(1, 1, At, B1); PG8_BAR;
            }
        }
        if constexpr (ALIGN_EPI) { if (wr == 0) PG8_BAR; }
        if constexpr (!Epi::AFTER_DRAIN) { E(acc, cur, wr, wc, fr, fq); S.done(cur); }
        if (!has_next) break;
#pragma unroll
        for (int a = 0; a < 2; ++a)
#pragma unroll
            for (int b = 0; b < 2; ++b)
#pragma unroll
                for (int m = 0; m < 4; ++m)
#pragma unroll
                    for (int n = 0; n < 2; ++n) acc[a][b][m][n] = (f32x4){0.f, 0.f, 0.f, 0.f};
        cur = nxt; cA = nA; cB = nB; ++ui;
        if constexpr (ALIGN_EPI) { if (wr == 1) PG8_BAR; }
    }
    PG8_WAIT_V(0);
    if constexpr (!ALIGN_EPI) { if (wr == 0) PG8_BAR; }
    PG8_BAR;
    if constexpr (Epi::AFTER_DRAIN) { E.fused(acc, cur, wr, wc, fr, fq, lds, wid, lane); S.done(cur); }
#undef PG8_SA
#undef PG8_SB
#undef PG8_STAGE
#undef PG8_LDA
#undef PG8_LDB
#undef PG8_MMA
#undef PG8_WAIT_V
#undef PG8_WAIT_L
#undef PG8_BAR
#undef PG8_SCHED
}
}
namespace fox {
typedef unsigned short bf16;
typedef short bf16x8 __attribute__((ext_vector_type(8)));
typedef short s16x4 __attribute__((ext_vector_type(4)));
typedef float f32x16 __attribute__((ext_vector_type(16)));
typedef float f32x4 __attribute__((ext_vector_type(4)));
typedef unsigned u32x4 __attribute__((ext_vector_type(4)));
#define FLAS __attribute__((address_space(3)))
constexpr int D = 128, PITCH = 2048, SEQ = 2048;
constexpr float SCALE = 0.08838834764831845f, INV_SCALE = 11.313708498984761f, THR = 8.f;
constexpr int NW = 8, QBLK = 32, KVBLK = 64, QB = NW * QBLK;
constexpr int SHM_V = KVBLK * D * 2, SHM_K = KVBLK * D * 2;
constexpr int LDS_WS = 2 * SHM_V + 2 * SHM_K, LDS_KB = LDS_WS + NW * 64 * 4, LDS_WT = LDS_KB + 4 * SEQ * 4, LDS_BYTES = LDS_WT + 64;
constexpr int WBIG = 1 << 30;
#define KSWZ(row, colB) ((row) * 256 + ((colB) ^ (((row) & 7) << 4)))
#define SBAR() __builtin_amdgcn_sched_barrier(0)
__device__ __forceinline__ int v_st(int k, int c) { const int kk = (k & ~0xC) | ((k & 4) << 1) | ((k & 8) >> 1); return ((kk >> 3) * 4 + (c >> 5)) * 512 + ((kk & 7) * 32 + (c & 31)) * 2; }
__device__ __forceinline__ int v_rd_base(int lane) { return ((lane & 3) << 3) | (((lane >> 2) & 3) << 6) | (((lane >> 4) & 1) << 5) | (((lane >> 5) & 1) << 8); }
constexpr int v_rd_off(int d0, int ks, int half) { return d0 * 512 + ks * 4096 + half * 2048; }
__device__ __forceinline__ int crow(int r, int hi) { return (r & 3) + 8 * (r >> 2) + 4 * hi; }
__device__ __forceinline__ unsigned cvtpk(float lo, float hi) { unsigned r; asm volatile("v_cvt_pk_bf16_f32 %0, %1, %2" : "=v"(r) : "v"(lo), "v"(hi)); return r; }
__device__ __forceinline__ bf16x8 load8(const bf16* p) { return *reinterpret_cast<const bf16x8*>(p); }
__device__ __forceinline__ void mask_tile(f32x16& p0, f32x16& p1, int dq, unsigned W) {
    const float NEG = -__builtin_inff();
#pragma unroll
    for (int r = 0; r < 16; ++r) {
        const int c = (r & 3) + 8 * (r >> 2);
        if ((unsigned)(dq - c) >= W) p0[r] = NEG;
        if ((unsigned)(dq - c - 32) >= W) p1[r] = NEG;
    }
}
__device__ __forceinline__ void partialSM(f32x16& p0, f32x16& p1, float& m_reg, float& mn, float& alpha) {
    float pmax = p0[0];
#pragma unroll
    for (int r = 1; r < 16; ++r) pmax = fmaxf(pmax, p0[r]);
#pragma unroll
    for (int r = 0; r < 16; ++r) pmax = fmaxf(pmax, p1[r]);
    { auto rr = __builtin_amdgcn_permlane32_swap(__float_as_uint(pmax), __float_as_uint(pmax), false, false);
      pmax = fmaxf(__uint_as_float(rr[0]), __uint_as_float(rr[1])); }
    constexpr float C2 = 1.4426950408889634f * SCALE;
    if (__builtin_expect(__all((pmax - m_reg) * SCALE <= THR), 1)) { mn = m_reg; alpha = 1.f; }
    else { mn = fmaxf(m_reg, pmax); alpha = __builtin_amdgcn_exp2f((m_reg - mn) * C2); m_reg = mn; }
    const float mnL = -mn * C2;
#pragma unroll
    for (int r = 0; r < 16; ++r) p0[r] = fmaf(p0[r], C2, mnL);
#pragma unroll
    for (int r = 0; r < 16; ++r) p1[r] = fmaf(p1[r], C2, mnL);
#pragma unroll
    for (int r = 0; r < 16; ++r) p0[r] = __builtin_amdgcn_exp2f(p0[r]);
}
#define PK4(P, B_, OUT) do { unsigned a0 = cvtpk(P[B_+0], P[B_+1]), a1 = cvtpk(P[B_+2], P[B_+3]);                          \
        unsigned b0 = cvtpk(P[B_+4], P[B_+5]), b1 = cvtpk(P[B_+6], P[B_+7]);                                             \
        auto r0 = __builtin_amdgcn_permlane32_swap(a0, b0, false, false); auto r1 = __builtin_amdgcn_permlane32_swap(a1, b1, false, false); \
        u32x4 w = {r0[0], r1[0], r0[1], r1[1]}; OUT = *reinterpret_cast<bf16x8*>(&w); } while (0)
__device__ __forceinline__ void finishSM(f32x16& p0, f32x16& p1, float alpha, float& l_reg, bf16x8& pa0, bf16x8& pa1, bf16x8& pa2, bf16x8& pa3) {
#pragma unroll
    for (int r = 0; r < 16; ++r) p1[r] = __builtin_amdgcn_exp2f(p1[r]);
    float ps = 0;
#pragma unroll
    for (int r = 0; r < 16; ++r) ps += p0[r];
#pragma unroll
    for (int r = 0; r < 16; ++r) ps += p1[r];
    { auto rr = __builtin_amdgcn_permlane32_swap(__float_as_uint(ps), __float_as_uint(ps), false, false);
      ps = __uint_as_float(rr[0]) + __uint_as_float(rr[1]); }
    l_reg = l_reg * alpha + ps;
    PK4(p0, 0, pa0); PK4(p0, 8, pa1); PK4(p1, 0, pa2); PK4(p1, 8, pa3);
}
template <int KB>
__device__ __forceinline__ void qkt(f32x16& p0, f32x16& p1, const char* K_lds, int r32, int hi, const bf16x8* qr, const FLAS float* kbp) {
#pragma unroll
    for (int g = 0; g < 4; ++g) { const f32x4 v0 = *(const FLAS f32x4*)(kbp + 8 * g), v1 = *(const FLAS f32x4*)(kbp + 32 + 8 * g);
#pragma unroll
        for (int e = 0; e < 4; ++e) { p0[4 * g + e] = v0[e]; p1[4 * g + e] = v1[e]; } }
    const char* kb[4];
#pragma unroll
    for (int dd = 0; dd < 4; ++dd) kb[dd] = K_lds + KB * SHM_K + KSWZ(r32, (dd * 16 + hi * 8) * 2);
#pragma unroll
    for (int d0 = 0; d0 < 8; ++d0) { const char* a = kb[d0 & 3] + (d0 >> 2) * 128;
        bf16x8 b0 = *reinterpret_cast<const bf16x8*>(a);
        bf16x8 b1 = *reinterpret_cast<const bf16x8*>(a + 32 * 256);
        p0 = __builtin_amdgcn_mfma_f32_32x32x16_bf16(b0, qr[d0], p0, 0, 0, 0);
        p1 = __builtin_amdgcn_mfma_f32_32x32x16_bf16(b1, qr[d0], p1, 0, 0, 0); }
}
template <int VB>
__device__ __forceinline__ void pv_tile(f32x16* o, int vb0, bf16x8 pa0, bf16x8 pa1, bf16x8 pa2, bf16x8 pa3) {
#define TRRD(dst, off) asm volatile("ds_read_b64_tr_b16 %0, %1 offset:%2" : "=&v"(dst) : "v"(vb0), "i"(off) : "memory")
#define PV_D0(d0) do { s16x4 l0, l1, l2, l3, h0, h1, h2, h3; constexpr int b_ = VB * SHM_V + v_rd_off(d0, 0, 0); \
        TRRD(l0, b_); TRRD(h0, b_ + 2048); TRRD(l1, b_ + 4096); TRRD(h1, b_ + 6144); TRRD(l2, b_ + 8192); TRRD(h2, b_ + 10240); TRRD(l3, b_ + 12288); TRRD(h3, b_ + 14336); \
        asm volatile("s_waitcnt lgkmcnt(0)" ::: "memory"); SBAR(); \
        o[d0] = __builtin_amdgcn_mfma_f32_32x32x16_bf16(pa0, (bf16x8){l0[0], l0[1], l0[2], l0[3], h0[0], h0[1], h0[2], h0[3]}, o[d0], 0, 0, 0);   \
        o[d0] = __builtin_amdgcn_mfma_f32_32x32x16_bf16(pa1, (bf16x8){l1[0], l1[1], l1[2], l1[3], h1[0], h1[1], h1[2], h1[3]}, o[d0], 0, 0, 0);   \
        o[d0] = __builtin_amdgcn_mfma_f32_32x32x16_bf16(pa2, (bf16x8){l2[0], l2[1], l2[2], l2[3], h2[0], h2[1], h2[2], h2[3]}, o[d0], 0, 0, 0);   \
        o[d0] = __builtin_amdgcn_mfma_f32_32x32x16_bf16(pa3, (bf16x8){l3[0], l3[1], l3[2], l3[3], h3[0], h3[1], h3[2], h3[3]}, o[d0], 0, 0, 0); } while (0)
    PV_D0(0); PV_D0(1); PV_D0(2); PV_D0(3);
#undef PV_D0
#undef TRRD
}
struct BlockRef { const bf16* Q; const bf16* K; const bf16* V; bf16* O; const float* lf; int P0; };
struct Seam { bf16x8 qr[8]; bf16x8 st_v0, st_v1, st_k0, st_k1; };
#define ROW(p, k0, rr) ((p) + (size_t)((k0) + (rr)) * PITCH + sc)
#define VMW() asm volatile("s_waitcnt vmcnt(0)" ::: "memory")
#define VMWN(n) asm volatile("s_waitcnt vmcnt(%0)" :: "i"(n) : "memory")
#define SLOAD_H(Kp, Vp, k0) do { const bf16* kq_ = (Kp) + (size_t)(k0) * PITCH; const bf16* vq_ = (Vp) + (size_t)(k0) * PITCH; \
                         S.st_v0 = load8(vq_ + soff); S.st_v1 = load8(vq_ + 32 * PITCH + soff); S.st_k0 = load8(kq_ + soff); S.st_k1 = load8(kq_ + 32 * PITCH + soff); } while (0)
#define SWRITE_HK(bf) do { *(bf16x8*)(K_lds + (bf) * SHM_K + kws) = S.st_k0; *(bf16x8*)(K_lds + (bf) * SHM_K + kws + 32 * 256) = S.st_k1; } while (0)
#define SWRITE_HV(bf) do { *(bf16x8*)(V_lds + (bf) * SHM_V + vst0) = S.st_v0; *(bf16x8*)(V_lds + (bf) * SHM_V + vst1) = S.st_v1; } while (0)
#define SWRITE_H(bf) do { SWRITE_HV(bf); SWRITE_HK(bf); } while (0)
__device__ __forceinline__ void prime(const BlockRef& cur, char* lds, Seam& S) {
    const int tid = opaque_tid(), wid = __builtin_amdgcn_readfirstlane(tid >> 6), lane = tid & 63, r32 = lane & 31, hi = lane >> 5;
    const int sr = tid >> 4, sc = (tid & 15) * 8, kws = KSWZ(sr, sc * 2); char* K_lds = lds + 2 * SHM_V; const unsigned soff = sr * PITCH + sc, qoff = r32 * PITCH + hi * 8;
    { const bf16* qb_ = cur.Q + (size_t)(wid * QBLK) * PITCH;
#pragma unroll
    for (int d0 = 0; d0 < 8; ++d0) S.qr[d0] = load8(qb_ + qoff + d0 * 16); }
    SLOAD_H(cur.K, cur.V, 0); VMW(); SWRITE_HK(0);
    __syncthreads();
}
__device__ __forceinline__ void key_bias(const BlockRef& cur, char* lds, int slot) {
    const int tid = opaque_tid(), wid = __builtin_amdgcn_readfirstlane(tid >> 6), lane = tid & 63;
    FLAS float* kb = (FLAS float*)(lds + LDS_KB) + slot * SEQ; FLAS float* wt = (FLAS float*)(lds + LDS_WT);
    const int n = cur.P0 + QB; const bool act = 4 * tid < n;
    float lf[4];
#pragma unroll
    for (int j = 0; j < 4; ++j) lf[j] = act ? cur.lf[(size_t)(4 * tid + j) * 16] : 0.f;
    lf[1] += lf[0]; lf[2] += lf[1]; lf[3] += lf[2];
    float tot = lf[3];
#pragma unroll
    for (int o = 1; o < 64; o <<= 1) { const float t = __shfl_up(tot, o); if (lane >= o) tot += t; }
    if (lane == 63) wt[wid] = tot;
    __syncthreads();
    float off = tot - lf[3];
#pragma unroll
    for (int w = 0; w < 8; ++w) { const float t = wt[w]; if (w < wid) off += t; }
    if (4 * tid == cur.P0) wt[8] = off + lf[0];
    __syncthreads();
    const float cref = wt[8];
    f32x4 o4; o4[0] = (cref - (off + lf[0])) * INV_SCALE; o4[1] = (cref - (off + lf[1])) * INV_SCALE; o4[2] = (cref - (off + lf[2])) * INV_SCALE; o4[3] = (cref - (off + lf[3])) * INV_SCALE;
    *(FLAS f32x4*)(kb + 4 * tid) = o4;
    __syncthreads();
}
__device__ __forceinline__ void block(const BlockRef& cur, const BlockRef& nxt, char* lds, Seam& S, int slot) {
    const int tid = opaque_tid(), wid = __builtin_amdgcn_readfirstlane(tid >> 6), lane = tid & 63, r32 = lane & 31, hi = lane >> 5;
    constexpr int W = WBIG;
    const int NT = (cur.P0 + QB - 1) / KVBLK + 1;
    const int qlo = cur.P0 + wid * QBLK, qm = qlo + r32 - 4 * hi;
    char* V_lds = lds; char* K_lds = lds + 2 * SHM_V;
    float* ws = (float*)(lds + LDS_WS) + wid * 64; float* li_l = ws, * al_l = ws + 32;
    const FLAS float* kbl = (const FLAS float*)(lds + LDS_KB) + slot * SEQ + 4 * hi;
    float m_reg = -1e30f, l_reg = 0; f32x16 o[4] = {};
    const int sr = tid >> 4, sc = (tid & 15) * 8, vst0 = v_st(sr, sc), vst1 = v_st(32 + sr, sc), kws = KSWZ(sr, sc * 2); const unsigned soff = sr * PITCH + sc, qoff = r32 * PITCH + hi * 8;
    const int vb0 = (int)(uintptr_t)V_lds + v_rd_base(lane);
    const bf16* Kh = cur.K; const bf16* Vh = cur.V;
#define RESC(a) do { if (__any((a) < 1.f)) { if (hi == 0) al_l[r32] = (a); asm volatile("s_waitcnt lgkmcnt(0)" ::: "memory");              \
                     for (int d_ = 0; d_ < 4; ++d_) for (int r = 0; r < 16; ++r) o[d_][r] *= al_l[crow(r, hi)]; } } while (0)
#define KBASE(t) ((t) * KVBLK)
#define MASKT(P0_, P1_, t) do { const int kb_ = KBASE(t); if (kb_ + KVBLK - 1 > qlo) mask_tile(P0_, P1_, qm - kb_, (unsigned)W); } while (0)
#define SEAM_K0() do { VMWN(8); SWRITE_HK(0); SBAR(); } while (0)
    f32x16 pA0, pA1, pB0, pB1; float mnA, mnB, alA, alB; bf16x8 pa0, pa1, pa2, pa3;
    SWRITE_HV(0); SBAR();
    if (NT > 1) { SLOAD_H(Kh, Vh, KBASE(1)); }
    SBAR(); qkt<0>(pA0, pA1, K_lds, r32, hi, S.qr, kbl + KBASE(0));
    MASKT(pA0, pA1, 0); partialSM(pA0, pA1, m_reg, mnA, alA);
    if (NT > 1) { VMW(); SWRITE_H(1); }
    __syncthreads();
#define HALF_STEP(PX0, PX1, mnX, alX, PY0, PY1, alY, t, KB, VB, SB) do {                                                      \
        SBAR(); qkt<KB>(PX0, PX1, K_lds, r32, hi, S.qr, kbl + KBASE(t));                                                          \
        finishSM(PY0, PY1, alY, l_reg, pa0, pa1, pa2, pa3); SBAR();                                                           \
        if ((t) + 1 < NT) { SLOAD_H(Kh, Vh, KBASE((t) + 1)); SBAR(); }                                               \
        pv_tile<VB>(o, vb0, pa0, pa1, pa2, pa3); MASKT(PX0, PX1, (t)); partialSM(PX0, PX1, m_reg, mnX, alX);   \
        __syncthreads();                                                                                                      \
        if ((t) + 1 < NT) { VMW(); SWRITE_H(SB); }                                                                          \
        RESC(alX); __syncthreads(); } while (0)
    for (int t = 1; t + 1 < NT; t += 2) {
        HALF_STEP(pB0, pB1, mnB, alB, pA0, pA1, alA, t, 1, 0, 0);
        HALF_STEP(pA0, pA1, mnA, alA, pB0, pB1, alB, t + 1, 0, 1, 1);
    }
    const bool even = (NT & 1) == 0;
    if (even) { SBAR(); qkt<1>(pB0, pB1, K_lds, r32, hi, S.qr, kbl + KBASE(NT - 1)); SBAR(); }
    SLOAD_H(nxt.K, nxt.V, 0); SBAR();
    { const bf16* qb_ = nxt.Q + (size_t)(wid * QBLK) * PITCH;
#pragma unroll
    for (int d0 = 0; d0 < 8; ++d0) S.qr[d0] = load8(qb_ + qoff + d0 * 16); }
    SBAR();
    finishSM(pA0, pA1, alA, l_reg, pa0, pa1, pa2, pa3); SBAR();
    pv_tile<0>(o, vb0, pa0, pa1, pa2, pa3);
    if (even) { MASKT(pB0, pB1, NT - 1); partialSM(pB0, pB1, m_reg, mnB, alB); __syncthreads(); RESC(alB);
        finishSM(pB0, pB1, alB, l_reg, pa0, pa1, pa2, pa3); SBAR(); pv_tile<1>(o, vb0, pa0, pa1, pa2, pa3); }
    SBAR(); SEAM_K0();
    if (hi == 0) li_l[r32] = l_reg; asm volatile("s_waitcnt lgkmcnt(0)" ::: "memory");
    float rli[16];
#pragma unroll
    for (int r = 0; r < 16; ++r) rli[r] = __builtin_amdgcn_rcpf(li_l[crow(r, hi)]);
    bf16* Ow = cur.O + (size_t)(wid * QBLK) * PITCH; const unsigned ooff = 4 * hi * PITCH + r32;
#pragma unroll
    for (int r = 0; r < 16; ++r) { const int orow = crow(r, hi);
#pragma unroll
        for (int d0 = 0; d0 < 4; ++d0) { const float v = o[d0][r] * rli[r];
            const float vn = __shfl_xor(v, 1);
            if ((r32 & 1) == 0) *(unsigned*)(Ow + ((r & 3) + 8 * (r >> 2)) * PITCH + d0 * 32 + ooff) = cvtpk(v, vn); } }
    __syncthreads();
#undef RESC
#undef KBASE
#undef MASKT
#undef SEAM_K0
#undef HALF_STEP
}
#undef ROW
#undef VMW
#undef VMWN
#undef SLOAD_H
#undef SWRITE_HK
#undef SWRITE_HV
#undef SWRITE_H
}
namespace swa {
typedef unsigned short bf16;
typedef short bf16x8 __attribute__((ext_vector_type(8)));
typedef short s16x4 __attribute__((ext_vector_type(4)));
typedef float f32x16 __attribute__((ext_vector_type(16)));
typedef float f32x4 __attribute__((ext_vector_type(4)));
typedef unsigned u32x4 __attribute__((ext_vector_type(4)));
#define SLAS __attribute__((address_space(3)))
using fox::cvtpk;
constexpr int QKVP = 2560, OP = 2048, KROW = 144;
constexpr int LDS_K = 0, LDS_V = 256 * KROW, LDS_WS = LDS_V + 256 * 64 * 2, LDS_BYTES = LDS_WS + 8 * 256;
__device__ __forceinline__ int v_st2(int k, int c) { const int kk = (k & ~0xC) | ((k & 4) << 1) | ((k & 8) >> 1); return ((kk >> 3) * 2 + (c >> 5)) * 512 + ((kk & 7) * 32 + (c & 31)) * 2; }
__device__ __forceinline__ float bf_lo(unsigned w) { return __uint_as_float(w << 16); }
__device__ __forceinline__ float bf_hi(unsigned w) { return __uint_as_float(w & 0xffff0000u); }
__device__ __forceinline__ u32x4 rope8(u32x4 own, u32x4 oth, const float* tab, bool second) {
    const f32x4 c0 = *(const f32x4*)(tab), c1 = *(const f32x4*)(tab + 4), s0 = *(const f32x4*)(tab + 8), s1 = *(const f32x4*)(tab + 12);
    const float sg = second ? 1.f : -1.f;
    float cs[8] = {c0[0], c0[1], c0[2], c0[3], c1[0], c1[1], c1[2], c1[3]}, sn[8] = {s0[0], s0[1], s0[2], s0[3], s1[0], s1[1], s1[2], s1[3]};
    u32x4 r;
#pragma unroll
    for (int i = 0; i < 4; ++i) { const float a0 = bf_lo(own[i]), a1 = bf_hi(own[i]), b0 = bf_lo(oth[i]), b1 = bf_hi(oth[i]);
        const float o0 = a0 * cs[2 * i] + sg * b0 * sn[2 * i], o1 = a1 * cs[2 * i + 1] + sg * b1 * sn[2 * i + 1];
        r[i] = fox::cvtpk(o0, o1); }
    return r;
}
__device__ __forceinline__ void unit(int b, int n, int hk, const bf16* QKV, bf16* O, const float* rope, const float* sinks, char* lds) {
    const int tid = opaque_tid(), wid = __builtin_amdgcn_readfirstlane(tid >> 6), lane = tid & 63, r32 = lane & 31, hi = lane >> 5;
    const bf16* base = QKV + (size_t)(b * 2048) * QKVP;
    SLAS char* l3 = (SLAS char*)lds;
#pragma unroll
    for (int i = 0; i < 4; ++i) { const int row = i * 64 + (tid >> 3), c = tid & 7, s = 128 * (n - 1) + row; const bool valid = s >= 0;
        u32x4 kv = {0u, 0u, 0u, 0u}, vv = {0u, 0u, 0u, 0u};
        if (valid) { kv = *(const u32x4*)(base + (size_t)s * QKVP + 2048 + hk * 64 + 8 * c); vv = *(const u32x4*)(base + (size_t)s * QKVP + 2304 + hk * 64 + 8 * c); }
        u32x4 ot; ot[0] = __shfl_xor(kv[0], 1); ot[1] = __shfl_xor(kv[1], 1); ot[2] = __shfl_xor(kv[2], 1); ot[3] = __shfl_xor(kv[3], 1);
        if (c < 2 && valid) kv = rope8(kv, ot, rope + (size_t)(b * 2048 + s) * 16, c == 1);
        *(SLAS u32x4*)(l3 + LDS_K + row * KROW + c * 16) = kv;
        *(SLAS u32x4*)(l3 + LDS_V + v_st2(row, 8 * c)) = vv; }
    __syncthreads();
    const int hq = hk * 8 + wid;
    const float sinkL = sinks[hq] * 1.4426950408889634f;
    constexpr float C2 = 0.125f * 1.4426950408889634f;
    const int vb0 = LDS_V + fox::v_rd_base(lane);
    SLAS float* li_l = (SLAS float*)(l3 + LDS_WS + wid * 256);
    for (int c4 = 0; c4 < 4; ++c4) {
        const int qrow = b * 2048 + 128 * n + 32 * c4 + r32;
        bf16x8 qr[4];
#pragma unroll
        for (int ks = 0; ks < 4; ++ks) qr[ks] = *(const bf16x8*)(base + (size_t)(128 * n + 32 * c4 + r32) * QKVP + hq * 64 + 16 * ks + 8 * hi);
        { u32x4 own = __builtin_bit_cast(u32x4, qr[0]); u32x4 ot; ot[0] = __shfl_xor(own[0], 32); ot[1] = __shfl_xor(own[1], 32); ot[2] = __shfl_xor(own[2], 32); ot[3] = __shfl_xor(own[3], 32);
          own = rope8(own, ot, rope + (size_t)qrow * 16, hi == 1); qr[0] = __builtin_bit_cast(bf16x8, own); }
        f32x16 p[5];
#pragma unroll
        for (int jb = 0; jb < 5; ++jb) { p[jb] = f32x16{};
            const SLAS char* kp = l3 + LDS_K + (32 * c4 + 32 * jb + r32) * KROW + hi * 16;
#pragma unroll
            for (int ks = 0; ks < 4; ++ks) { const bf16x8 a = *(const SLAS bf16x8*)(kp + ks * 32); p[jb] = __builtin_amdgcn_mfma_f32_32x32x16_bf16(a, qr[ks], p[jb], 0, 0, 0); } }
        float mx = sinkL;
#pragma unroll
        for (int jb = 0; jb < 5; ++jb) { const bool dead = (n == 0) && (c4 + jb < 4);
#pragma unroll
            for (int r = 0; r < 16; ++r) { const int rel = r32 + 128 - 32 * jb - fox::crow(r, hi); const bool ok = ((unsigned)rel < 128u) && !dead;
                const float t = ok ? p[jb][r] * C2 : -__builtin_inff(); p[jb][r] = t; mx = fmaxf(mx, t); } }
        { auto rr = __builtin_amdgcn_permlane32_swap(__float_as_uint(mx), __float_as_uint(mx), false, false); mx = fmaxf(__uint_as_float(rr[0]), __uint_as_float(rr[1])); }
        float ps = 0.f;
#pragma unroll
        for (int jb = 0; jb < 5; ++jb)
#pragma unroll
            for (int r = 0; r < 16; ++r) { const float e = __builtin_amdgcn_exp2f(p[jb][r] - mx); p[jb][r] = e; ps += e; }
        { auto rr = __builtin_amdgcn_permlane32_swap(__float_as_uint(ps), __float_as_uint(ps), false, false); ps = __uint_as_float(rr[0]) + __uint_as_float(rr[1]); }
        ps += __builtin_amdgcn_exp2f(sinkL - mx);
        f32x16 o[2]; o[0] = f32x16{}; o[1] = f32x16{};
#pragma unroll
        for (int jb = 0; jb < 5; ++jb) { bf16x8 pa0, pa1; PK4(p[jb], 0, pa0); PK4(p[jb], 8, pa1);
            const SLAS char* vp = l3 + vb0 + (2 * c4 + 2 * jb) * 2048;
#pragma unroll
            for (int d0 = 0; d0 < 2; ++d0) {
                const s16x4 l0 = __builtin_bit_cast(s16x4, __builtin_amdgcn_ds_read_tr16_b64_v4i16((SLAS s16x4*)(vp + d0 * 512)));
                const s16x4 h0 = __builtin_bit_cast(s16x4, __builtin_amdgcn_ds_read_tr16_b64_v4i16((SLAS s16x4*)(vp + d0 * 512 + 1024)));
                const s16x4 l1 = __builtin_bit_cast(s16x4, __builtin_amdgcn_ds_read_tr16_b64_v4i16((SLAS s16x4*)(vp + d0 * 512 + 2048)));
                const s16x4 h1 = __builtin_bit_cast(s16x4, __builtin_amdgcn_ds_read_tr16_b64_v4i16((SLAS s16x4*)(vp + d0 * 512 + 3072)));
                o[d0] = __builtin_amdgcn_mfma_f32_32x32x16_bf16(pa0, (bf16x8){l0[0], l0[1], l0[2], l0[3], h0[0], h0[1], h0[2], h0[3]}, o[d0], 0, 0, 0);
                o[d0] = __builtin_amdgcn_mfma_f32_32x32x16_bf16(pa1, (bf16x8){l1[0], l1[1], l1[2], l1[3], h1[0], h1[1], h1[2], h1[3]}, o[d0], 0, 0, 0); } }
        if (hi == 0) li_l[r32] = ps;
        asm volatile("s_waitcnt lgkmcnt(0)" ::: "memory");
        bf16* Ow = O + (size_t)(b * 2048 + 128 * n + 32 * c4) * OP + hq * 64;
#pragma unroll
        for (int r = 0; r < 16; ++r) { const int orow = fox::crow(r, hi); const float rl = __builtin_amdgcn_rcpf(li_l[orow]);
#pragma unroll
            for (int d0 = 0; d0 < 2; ++d0) { const float v = o[d0][r] * rl; const float vn = __shfl_xor(v, 1);
                if ((r32 & 1) == 0) *(unsigned*)(Ow + (size_t)orow * OP + d0 * 32 + r32) = fox::cvtpk(v, vn); } }
        asm volatile("s_waitcnt lgkmcnt(0)" ::: "memory");
    }
    __syncthreads();
}
}
#define LAS __attribute__((address_space(3)))
typedef unsigned short bf16_t;
typedef float f32x4 __attribute__((ext_vector_type(4)));
typedef unsigned u32x4 __attribute__((ext_vector_type(4)));
typedef unsigned u32x2 __attribute__((ext_vector_type(2)));
typedef short bf16x8 __attribute__((ext_vector_type(8)));
constexpr int M = 16384, DM = 2048, SEQ = 2048, NB = 8, DFF = 5632, NFIN = 6160, NSIN = 2560;
constexpr float LN_EPS = 1e-5f, ALPHA = 1.4142135623730951f;
constexpr size_t MiB = 1u << 20;
constexpr size_t WS_MOD = 1 * MiB;
constexpr size_t WS_STATS = 1 * MiB + 786432;
constexpr size_t WS_ROPE = 2 * MiB;
constexpr size_t WS_LOGF = 3 * MiB;
constexpr size_t WS_UBUF = 4 * MiB;
constexpr size_t WS_WFIN = 16 * MiB;
constexpr size_t WS_WFO = 42 * MiB;
constexpr size_t WS_WSIN = 50 * MiB;
constexpr size_t WS_WSO = 60 * MiB;
constexpr size_t WS_WUP = 68 * MiB;
constexpr size_t WS_WDN = 156 * MiB;
constexpr size_t WS_H = 200 * MiB;
constexpr size_t WS_Z = 264 * MiB;
constexpr size_t WS_Q = 392 * MiB;
constexpr size_t WS_K = 456 * MiB, WS_V = 520 * MiB;
constexpr size_t WS_O = 584 * MiB;
constexpr size_t WS_END = 648 * MiB;
static_assert(WSO_MOD == WS_MOD && WSO_STATS == WS_STATS && WSO_Z == WS_Z && WSO_UBUF == WS_UBUF && WSO_Q == WS_Q, "ws map");
constexpr int LDS_HALO = 131072, LDS_PTAB = 139264, LDS_XB = 139264 + 512, LDS_BYTES = 147456;

__device__ __forceinline__ unsigned pk2(float lo, float hi) { return pg8::cvt_pk_bf16(lo, hi); }
__device__ __forceinline__ float wave_sum(float v) {
#pragma unroll
    for (int o = 1; o < 64; o <<= 1) v += __shfl_xor(v, o);
    return v;
}
__device__ __forceinline__ int perm_up(int n) { const int half = n >= DFF ? 1 : 0, ch = n - half * DFF; return (ch >> 7) * 256 + half * 128 + (ch & 127); }
template <int MODE> __device__ __forceinline__ void tr_item(const float* W, int K, int N, bf16_t* WT, LAS float* scr, int item, int lane) {
    const int nblk = (N + 31) / 32, kb = item / nblk, nb = item % nblk, k0 = 64 * kb, n0 = 32 * nb;
    const int nn = n0 + (lane & 31); const bool ok = nn < N;
#pragma unroll 8
    for (int i = 0; i < 32; ++i) { const int kk = 2 * i + (lane >> 5); scr[kk * 33 + (lane & 31)] = ok ? W[(size_t)(k0 + kk) * N + nn] : 0.f; }
    asm volatile("s_waitcnt lgkmcnt(0)" ::: "memory");
    const int c = lane & 7;
#pragma unroll
    for (int j = 0; j < 4; ++j) { const int n = (lane >> 3) + 8 * j; const LAS float* s = scr + (8 * c) * 33 + n;
        u32x4 o; o.x = pk2(s[0 * 33], s[1 * 33]); o.y = pk2(s[2 * 33], s[3 * 33]); o.z = pk2(s[4 * 33], s[5 * 33]); o.w = pk2(s[6 * 33], s[7 * 33]);
        const int ng = n0 + n; if (ng < N) { const int dr = MODE == 1 ? perm_up(ng) : ng; *(u32x4*)(WT + (size_t)dr * K + k0 + 8 * c) = o; } }
    asm volatile("s_waitcnt lgkmcnt(0)" ::: "memory");
}
__device__ __forceinline__ float log_sigmoid(float x) { return fminf(x, 0.f) - log1pf(expf(-fabsf(x))); }

#define XB_TMO      128
#define XB_XCNT(j)  (256  + 64 * (j))
#define XB_XSUB(j)  (1280 + 64 * (j))
#define XB_XGEN(j)  (2304 + 64 * (j))
#define XB_TOP      3328
#define XB_TOPGEN   3392
#define XCD_BAR_WORDS 3456
#define XB_SPIN_CAP (1u << 18)

__device__ __forceinline__ unsigned xb_ld(unsigned* p)              { return __hip_atomic_load(p, __ATOMIC_RELAXED, __HIP_MEMORY_SCOPE_AGENT); }
__device__ __forceinline__ unsigned xb_add(unsigned* p, unsigned v) { return __hip_atomic_fetch_add(p, v, __ATOMIC_RELAXED, __HIP_MEMORY_SCOPE_AGENT); }
__device__ __forceinline__ unsigned xb_xcc_id() { return (unsigned)__builtin_amdgcn_s_getreg((3 << 11) | 20) & 0xFu; }
#define XB_SPIN(cond, bar) do { unsigned _sp = 0; while (cond) { __builtin_amdgcn_s_sleep(1); \
    if ((++_sp & 255u) == 0u) { if (xb_ld(&(bar)[XB_TMO])) break; if (_sp > XB_SPIN_CAP) { atomicAdd(&(bar)[XB_TMO], 1u); break; } } } } while (0)

struct XcdBarrier {
    unsigned* bar; unsigned x;
    volatile LAS unsigned* st;
};

__device__ __forceinline__ XcdBarrier xcd_barrier_post(unsigned* bar, volatile LAS unsigned* st) {
    XcdBarrier b; b.bar = bar; b.x = xb_xcc_id(); b.st = st;
    if (threadIdx.x == 0) (void)xb_add(&bar[XB_XCNT(b.x)], 1u);
    return b;
}
__device__ __forceinline__ void xcd_barrier_complete(unsigned* bar, unsigned x, unsigned& nloc, unsigned& nx) {
    const unsigned G = gridDim.x * gridDim.y * gridDim.z;
    unsigned sum, cnt, mine, sp = 0u;
    for (;;) {
        sum = 0u; cnt = 0u; mine = 0u;
#pragma unroll
        for (unsigned j = 0; j < 16; ++j) { const unsigned c = xb_ld(&bar[XB_XCNT(j)]); sum += c; cnt += (c > 0u) ? 1u : 0u; mine = (j == x) ? c : mine; }
        if (sum == G) break;
        __builtin_amdgcn_s_sleep(1);
        if ((++sp & 255u) == 0u) { if (xb_ld(&bar[XB_TMO])) break; if (sp > XB_SPIN_CAP) { atomicAdd(&bar[XB_TMO], 1u); break; } }
    }
    nloc = mine > 0u ? mine : 1u; nx = cnt > 0u ? cnt : 1u;
}

__device__ __forceinline__ void xcd_barrier(const XcdBarrier& b) {
    asm volatile("s_waitcnt vmcnt(0)" ::: "memory");
    __syncthreads();
    if (threadIdx.x == 0) {
        unsigned* bar = b.bar;
        __builtin_amdgcn_s_waitcnt(0);
        unsigned nloc = b.st[0], nx = b.st[1];
        if (nloc == 0u) { xcd_barrier_complete(bar, b.x, nloc, nx); b.st[0] = nloc; b.st[1] = nx; }
        const unsigned old = xb_add(&bar[XB_XSUB(b.x)], 1u);
        const unsigned gen = old / nloc;
        if (old + 1u == (gen + 1u) * nloc) {
            __builtin_amdgcn_fence(__ATOMIC_RELEASE, "agent");
            asm volatile("s_waitcnt vmcnt(0)" ::: "memory");
            const unsigned og = xb_add(&bar[XB_TOP], 1u);
            const unsigned tg = og / nx;
            if (og + 1u == (tg + 1u) * nx) xb_add(&bar[XB_TOPGEN], 1u);
            else XB_SPIN(xb_ld(&bar[XB_TOPGEN]) == tg, bar);
            __builtin_amdgcn_fence(__ATOMIC_ACQUIRE, "agent");
            xb_add(&bar[XB_XGEN(b.x)], 1u);
            asm volatile("s_waitcnt vmcnt(0)" ::: "memory");
        } else {
            XB_SPIN(xb_ld(&bar[XB_XGEN(b.x)]) == gen, bar);
            __builtin_amdgcn_fence(__ATOMIC_ACQUIRE, "agent");
            asm volatile("s_waitcnt vmcnt(0)" ::: "memory");
        }
    }
    __syncthreads();
}

#ifndef DUPMASK
#define DUPMASK 0
#endif
#define DUP(k) for (int rep_ = 0; rep_ < 1 + ((DUPMASK >> (k)) & 1); ++rep_)
#ifndef PH
#define PH 0xFFFF
#endif
#define ON(k) ((PH >> (k)) & 1)
struct Args { const void* in[19]; float* out; unsigned char* ws; };


__global__ void __launch_bounds__(512, 2) fwd_kernel(Args a) {
    extern __shared__ __attribute__((aligned(16))) unsigned char lds[];
    cg::grid_group grid = cg::this_grid();
#define tid (opaque_tid())
#define lane (opaque_tid() & 63)
#define wid (__builtin_amdgcn_readfirstlane(opaque_tid() >> 6))
    constexpr int G = 256, NGW = G * 8;
#define bid ((int)blockIdx.x)
#define vcu ((bid % 8) * (G / 8) + bid / 8)
#define gw (bid * 8 + wid)
    ptab_t ptab = (ptab_t)(lds + LDS_PTAB);
    if (tid < 19) ptab[tid] = (unsigned long long)a.in[tid];
    if (tid == 19) ptab[19] = (unsigned long long)a.out;
    if (tid == 20) ptab[20] = (unsigned long long)a.ws;
    if (tid == 21) { ((LAS unsigned*)(lds + LDS_XB))[0] = 0u; ((LAS unsigned*)(lds + LDS_XB))[1] = 0u; }
    __syncthreads();
    (void)xcd_barrier_post((unsigned*)a.ws, (volatile LAS unsigned*)(lds + LDS_XB));
    if (a.out == nullptr) grid.sync();
#define GBAR() do { XcdBarrier b_; b_.bar = (unsigned*)WSP; b_.x = xb_xcc_id(); b_.st = (volatile LAS unsigned*)(lds + LDS_XB); xcd_barrier(b_); } while (0)
#define LDP(i) ldp(ptab, (i))
#define x_in ((const float*)LDP(0))
#define c_in ((const float*)LDP(1))
#define pos_in ((const int*)LDP(2))
#define fox_w_in ((const float*)LDP(3))
#define fox_b_f ((const float*)LDP(4))
#define fox_w_o ((const float*)LDP(5))
#define swa_w_in ((const float*)LDP(6))
#define swa_sinks ((const float*)LDP(7))
#define swa_w_o ((const float*)LDP(8))
#define ada_w ((const float*)LDP(9))
#define ada_b ((const float*)LDP(10))
#define ffn_w_up ((const float*)LDP(11))
#define ffn_conv_w ((const float*)LDP(12))
#define ffn_conv_b ((const float*)LDP(13))
#define ffn_w_down ((const float*)LDP(14))
#define ln_mix_g ((const float*)LDP(15))
#define ln_mix_b ((const float*)LDP(16))
#define ln_ffn_g ((const float*)LDP(17))
#define ln_ffn_b ((const float*)LDP(18))
#define xcur ((float*)LDP(19))
#define WSP ((unsigned char*)LDP(20))
#define mod ((float*)(WSP + WS_MOD))
#define rope ((float*)(WSP + WS_ROPE))
#define stats_ ((float*)(WSP + WS_STATS))
#define logf_ ((float*)(WSP + WS_LOGF))
#define ubuf ((float*)(WSP + WS_UBUF))
#define Wfin ((bf16_t*)(WSP + WS_WFIN))
#define Wfo ((bf16_t*)(WSP + WS_WFO))
#define Wsin ((bf16_t*)(WSP + WS_WSIN))
#define Wso ((bf16_t*)(WSP + WS_WSO))
#define Wup ((bf16_t*)(WSP + WS_WUP))
#define Wdn ((bf16_t*)(WSP + WS_WDN))
#define Hb ((bf16_t*)(WSP + WS_H))
#define Zb ((float*)(WSP + WS_Z))
#define Qb ((bf16_t*)(WSP + WS_Q))
#define Kb ((bf16_t*)(WSP + WS_K))
#define Vb ((bf16_t*)(WSP + WS_V))
#define Ob ((bf16_t*)(WSP + WS_O))
#define Actb Qb

    DUP(0) {
    __syncthreads();
    if (ON(0)) {
        const int i = bid * 512 + tid;
        float* rope_ = rope; const int* pos_ = pos_in;
        if (i < M * 8) { const int m = i >> 3, f = i & 7; const float inv = (float)pow(500000.0, -(double)f / 8.0); const float ang = (float)pos_[m] * inv;
            rope_[m * 16 + f] = (float)cos((double)ang); rope_[m * 16 + 8 + f] = (float)sin((double)ang); }
    }
    if (ON(1) && bid < 192) {
        LAS float* sc = (LAS float*)lds; LAS float* red = (LAS float*)(lds + 65536);
        const float* cin_ = c_in; const float* adaw_ = ada_w; const float* adab_ = ada_b; float* mod_ = mod;
        for (int i = tid; i < NB * DM; i += 512) { const int b = i >> 11, k = i & 2047; const float v = cin_[i]; sc[k * 8 + b] = v / (1.f + expf(-v)); }
        __syncthreads();
        const int l = bid / 96, n0 = (bid % 96) * 128, kq = tid >> 5, cl = tid & 31;
        const float* W = adaw_ + (size_t)l * DM * 12288 + n0 + 4 * cl;
        f32x4 acc[8];
#pragma unroll
        for (int b = 0; b < 8; ++b) acc[b] = (f32x4){0.f, 0.f, 0.f, 0.f};
#pragma unroll 4
        for (int kk = 0; kk < 128; ++kk) { const int k = kq + 16 * kk; const f32x4 w = *(const f32x4*)(W + (size_t)k * 12288);
            const f32x4 s0 = *(const LAS f32x4*)(sc + k * 8), s1 = *(const LAS f32x4*)(sc + k * 8 + 4);
            acc[0] += w * s0[0]; acc[1] += w * s0[1]; acc[2] += w * s0[2]; acc[3] += w * s0[3]; acc[4] += w * s1[0]; acc[5] += w * s1[1]; acc[6] += w * s1[2]; acc[7] += w * s1[3]; }
#pragma unroll
        for (int b = 0; b < 8; ++b) *(LAS f32x4*)(red + (kq * 8 + b) * 128 + 4 * cl) = acc[b];
        __syncthreads();
        for (int o = tid; o < 1024; o += 512) { const int b = o >> 7, col = o & 127; float s = 0.f;
#pragma unroll
            for (int q = 0; q < 16; ++q) s += red[(q * 8 + b) * 128 + col];
            mod_[(size_t)(l * 8 + b) * 12288 + n0 + col] = s + adab_[l * 12288 + n0 + col]; }
        __syncthreads();
    }
    if (ON(2)) {
        LAS float* scr = (LAS float*)(lds + wid * 16384);
        const float* p_fin = fox_w_in; const float* p_fo = fox_w_o; const float* p_sin = swa_w_in; const float* p_so = swa_w_o; const float* p_up = ffn_w_up; const float* p_dn = ffn_w_down; unsigned char* wsl = WSP;
        constexpr int I_FIN = 32 * 193, I_SQ = 32 * 64, I_SIN = 32 * 80, I_UP = 32 * 352, I_DN = 88 * 64;
        constexpr int NITEMS = I_FIN + 2 * I_SQ + I_SIN + 2 * I_UP + 2 * I_DN;
        for (int it = gw; it < NITEMS; it += NGW) {
            int r = it;
            if (r < I_FIN) { tr_item<0>(p_fin, DM, NFIN, (bf16_t*)(wsl + WS_WFIN), scr, r, lane); continue; } r -= I_FIN;
            if (r < I_SQ) { tr_item<0>(p_fo, DM, DM, (bf16_t*)(wsl + WS_WFO), scr, r, lane); continue; } r -= I_SQ;
            if (r < I_SIN) { tr_item<0>(p_sin, DM, NSIN, (bf16_t*)(wsl + WS_WSIN), scr, r, lane); continue; } r -= I_SIN;
            if (r < I_SQ) { tr_item<0>(p_so, DM, DM, (bf16_t*)(wsl + WS_WSO), scr, r, lane); continue; } r -= I_SQ;
            if (r < 2 * I_UP) { const int l = r / I_UP; tr_item<1>(p_up + (size_t)l * DM * 2 * DFF, DM, 2 * DFF, (bf16_t*)(wsl + WS_WUP) + (size_t)l * 2 * DFF * DM, scr, r - l * I_UP, lane); continue; } r -= 2 * I_UP;
            { const int l = r / I_DN; tr_item<0>(p_dn + (size_t)l * DFF * DM, DFF, DM, (bf16_t*)(wsl + WS_WDN) + (size_t)l * DM * DFF, scr, r - l * I_DN, lane); }
        }
    }
    }
    GBAR();

    for (int l = 0; l < 2; ++l) {
#define modl (mod + (size_t)l * 8 * 12288)
        if (ON(3) && l == 0) {
            const float* xin_ = x_in; const float* mod0_ = modl; bf16_t* hb_ = Hb; const int ln_ = lane;
            for (int m = gw * 2; m < M; m += NGW * 2) { const float* sh = mod0_ + (size_t)(m >> 11) * 12288; const float* scv = sh + 2048;
                const f32x4* xr = (const f32x4*)(xin_ + (size_t)m * DM) + ln_; u32x2* ho = (u32x2*)(hb_ + (size_t)m * DM) + ln_; f32x4 v[2][8];
#pragma unroll
                for (int q = 0; q < 2; ++q)
#pragma unroll
                    for (int j = 0; j < 8; ++j) v[q][j] = xr[q * (DM / 4) + 64 * j];
#pragma unroll
                for (int j = 0; j < 8; ++j) { const f32x4 sv = *((const f32x4*)scv + ln_ + 64 * j) + 1.0f, tv = *((const f32x4*)sh + ln_ + 64 * j);
#pragma unroll
                    for (int q = 0; q < 2; ++q) { const f32x4 h = v[q][j] * sv + tv; u32x2 w; w.x = pk2(h[0], h[1]); w.y = pk2(h[2], h[3]); ho[q * (DM / 4) + 64 * j] = w; } } }
            GBAR();
        }
        if (l == 0) {
            if (ON(4) && wid < 4) { const int m0 = (bid * 4 + wid) * 16; const bf16_t* hb_ = Hb; const bf16_t* wf_ = Wfin; const float* bfp_ = fox_b_f; float* lfo_ = logf_;
                if (m0 < M) { const bf16_t* ap = hb_ + (size_t)(m0 + (lane & 15)) * DM + 8 * (lane >> 4); const bf16_t* bp = wf_ + (size_t)(6144 + (lane & 15)) * DM + 8 * (lane >> 4);
                    f32x4 c0 = {0.f, 0.f, 0.f, 0.f}, c1 = c0, c2 = c0, c3 = c0;
#pragma unroll 2
                    for (int kk = 0; kk < 64; kk += 4) {
                        c0 = __builtin_amdgcn_mfma_f32_16x16x32_bf16(*(const bf16x8*)(ap + kk * 32), *(const bf16x8*)(bp + kk * 32), c0, 0, 0, 0);
                        c1 = __builtin_amdgcn_mfma_f32_16x16x32_bf16(*(const bf16x8*)(ap + kk * 32 + 32), *(const bf16x8*)(bp + kk * 32 + 32), c1, 0, 0, 0);
                        c2 = __builtin_amdgcn_mfma_f32_16x16x32_bf16(*(const bf16x8*)(ap + kk * 32 + 64), *(const bf16x8*)(bp + kk * 32 + 64), c2, 0, 0, 0);
                        c3 = __builtin_amdgcn_mfma_f32_16x16x32_bf16(*(const bf16x8*)(ap + kk * 32 + 96), *(const bf16x8*)(bp + kk * 32 + 96), c3, 0, 0, 0); }
                    const f32x4 cs = (c0 + c1) + (c2 + c3); const float bf = bfp_[lane & 15];
#pragma unroll
                    for (int r = 0; r < 4; ++r) lfo_[(size_t)(m0 + (lane >> 4) * 4 + r) * 16 + (lane & 15)] = log_sigmoid(cs[r] + bf); } }
            DUP(8) if (ON(5)) { pg8::Gemm g{Hb, Wfin, M, 6144, DM}; pg8::StaticOrder S; S.init(M, 6144, G, bid);
              pg8::EpiBf16 E{ptab, DM, DM, (size_t)(WS_K - WS_Q) / 2};
              pg8::gemm_phase<pg8::EpiBf16, pg8::StaticOrder, true, true>((LAS unsigned char*)lds, g, S, E); }
            GBAR();
            DUP(2) if (ON(6)) {
                fox::Seam S;
                auto mk = [](int j, int vcu_, const bf16_t* Q, const bf16_t* K, const bf16_t* V, bf16_t* O, const float* lf) {
                    const int item = vcu_ + 256 * (j >> 1), bh = item >> 2, xq = item & 3, qb = (j & 1) ? 7 - xq : xq, b = bh >> 4, h = bh & 15;
                    fox::BlockRef r; const size_t ro = (size_t)(b * SEQ) * DM + h * 128;
                    r.Q = Q + ro + (size_t)(qb * 256) * DM; r.K = K + ro; r.V = V + ro; r.O = O + ro + (size_t)(qb * 256) * DM; r.lf = lf + (size_t)(b * SEQ) * 16 + h; r.P0 = qb * 256; return r; };
                { const float* lfp_ = logf_;
                  for (int j = 0; j < 4; ++j) { const fox::BlockRef r = mk(j, vcu, nullptr, nullptr, nullptr, nullptr, lfp_); fox::key_bias(r, (char*)lds, j); } }
                int vc2 = vcu; asm volatile("" : "+s"(vc2));
                const bf16_t* q_ = Qb; const bf16_t* k_ = Kb; const bf16_t* v_ = Vb; bf16_t* o_ = Ob;
                fox::BlockRef cur = mk(0, vc2, q_, k_, v_, o_, nullptr);
                fox::prime(cur, (char*)lds, S);
                for (int j = 0; j < 4; ++j) { const fox::BlockRef nxt = (j < 3) ? mk(j + 1, vc2, q_, k_, v_, o_, nullptr) : cur;
                    fox::block(cur, nxt, (char*)lds, S, j); cur = nxt; }
            }
            GBAR();
        } else {
            if (ON(7)) { pg8::Gemm g{Hb, Wsin, M, NSIN, DM}; pg8::StaticOrder S; S.init(M, NSIN, G, bid);
              pg8::EpiBf16 E{ptab, NSIN, 0, 0};
              pg8::gemm_phase<pg8::EpiBf16, pg8::StaticOrder, true, true>((LAS unsigned char*)lds, g, S, E); }
            GBAR();
            DUP(4) if (ON(8)) { const bf16_t* qkv_ = Qb; bf16_t* o_ = Ob; const float* rp_ = rope; const float* sk_ = swa_sinks;
              for (int u = vcu; u < 512; u += G) { const int hk = u & 3, n = (u >> 2) & 15, b = u >> 6; swa::unit(b, n, hk, qkv_, o_, rp_, sk_, (char*)lds); } }
            GBAR();
        }
        DUP(6) if (ON(9)) { pg8::Gemm g{Ob, l == 0 ? Wfo : Wso, M, DM, DM}; pg8::StaticOrder S; S.init(M, DM, G, bid);
          pg8::EpiZ E{ptab, l, 0};
          pg8::gemm_phase<pg8::EpiZ, pg8::StaticOrder, true, true>((LAS unsigned char*)lds, g, S, E); }
        GBAR();
#define LN_PHASE(GV, BV, SHV, SCV, WRITE_H, WRITE_X) do { const float* zb_ = Zb; float* xc_ = xcur; bf16_t* hb_ = Hb; float* st_ = stats_; const float* gv_ = (GV); const float* bv_ = (BV); const float* shv_ = (SHV); const float* scv_ = (SCV); \
        const int ln_ = lane; \
        for (int m = gw * 2; m < M; m += NGW * 2) { const f32x4* zr = (const f32x4*)(zb_ + (size_t)m * DM) + ln_; f32x4 v[2][8]; float s[2] = {0.f, 0.f}; \
            _Pragma("unroll") for (int q = 0; q < 2; ++q) _Pragma("unroll") for (int j = 0; j < 8; ++j) v[q][j] = zr[q * (DM / 4) + 64 * j]; \
            _Pragma("unroll") for (int q = 0; q < 2; ++q) _Pragma("unroll") for (int j = 0; j < 8; ++j) s[q] += (v[q][j][0] + v[q][j][1]) + (v[q][j][2] + v[q][j][3]); \
            float mean[2], rstd[2]; \
            _Pragma("unroll") for (int q = 0; q < 2; ++q) { mean[q] = wave_sum(s[q]) * (1.f / DM); float s2 = 0.f; \
                _Pragma("unroll") for (int j = 0; j < 8; ++j) { v[q][j] = v[q][j] - mean[q]; s2 += (v[q][j][0] * v[q][j][0] + v[q][j][1] * v[q][j][1]) + (v[q][j][2] * v[q][j][2] + v[q][j][3] * v[q][j][3]); } \
                rstd[q] = 1.f / sqrtf(wave_sum(s2) * (1.f / DM) + LN_EPS); } \
            if (ln_ < 2) { st_[2 * (m + ln_)] = ln_ ? mean[1] : mean[0]; st_[2 * (m + ln_) + 1] = ln_ ? rstd[1] : rstd[0]; } \
            const float* shp = shv_ + (size_t)(m >> 11) * 12288; const float* scp = scv_ + (size_t)(m >> 11) * 12288; \
            _Pragma("unroll") for (int j = 0; j < 8; ++j) { const f32x4 gg = *((const f32x4*)gv_ + ln_ + 64 * j), bb = *((const f32x4*)bv_ + ln_ + 64 * j); \
                f32x4 sv, tv; if (WRITE_H) { sv = *((const f32x4*)scp + ln_ + 64 * j) + 1.0f; tv = *((const f32x4*)shp + ln_ + 64 * j); } \
                _Pragma("unroll") for (int q = 0; q < 2; ++q) { const f32x4 y = v[q][j] * rstd[q] * gg + bb; \
                    if (WRITE_X) ((f32x4*)(xc_ + (size_t)(m + q) * DM) + ln_)[64 * j] = y; \
                    if (WRITE_H) { const f32x4 h = y * sv + tv; u32x2 w; w.x = pk2(h[0], h[1]); w.y = pk2(h[2], h[3]); ((u32x2*)(hb_ + (size_t)(m + q) * DM) + ln_)[64 * j] = w; } } } } } while (0)
        DUP(1) if (ON(10)) LN_PHASE(ln_mix_g + l * DM, ln_mix_b + l * DM, modl + 3 * 2048, modl + 4 * 2048, true, false);
        GBAR();
        DUP(3) if (ON(11)) { pg8::Gemm g{Hb, Wup + (size_t)l * 2 * DFF * DM, M, 2 * DFF, DM}; pg8::StaticOrder S; S.init(M, 2 * DFF, G, bid);
          pg8::EpiUp E{ptab, l, (LAS unsigned char*)lds + LDS_HALO};
          pg8::gemm_phase<pg8::EpiUp, pg8::StaticOrder, true, true>((LAS unsigned char*)lds, g, S, E); }
        GBAR();
        if (ON(12)) {
            const float* cw = ffn_conv_w + (size_t)l * 3 * 2 * DFF; const float* cb = ffn_conv_b + (size_t)l * 2 * DFF; const float* ub_ = ubuf; bf16_t* act_ = Actb;
            for (int i = bid * 512 + tid; i < 64 * 2 * (DFF / 4); i += G * 512) { const int pm = i / (2 * (DFF / 4)), rem = i % (2 * (DFF / 4)), r = rem / (DFF / 4), c4 = (rem % (DFF / 4)) * 4;
                if ((pm & 7) == 0) continue;
                f32x4 y[2];
#pragma unroll
                for (int hf = 0; hf < 2; ++hf) { const float* up = ub_ + ((size_t)((pm - 1) * 4) * 2 + hf) * DFF + c4; const float* uc = ub_ + ((size_t)(pm * 4) * 2 + hf) * DFF + c4;
                    const f32x4 um2 = *(const f32x4*)(up + (size_t)2 * 2 * DFF), um1 = *(const f32x4*)(up + (size_t)3 * 2 * DFF), u0 = *(const f32x4*)(uc), u1 = *(const f32x4*)(uc + (size_t)2 * DFF);
                    const int ci = hf * DFF + c4; const f32x4 w0 = *(const f32x4*)(cw + ci), w1 = *(const f32x4*)(cw + 2 * DFF + ci), w2 = *(const f32x4*)(cw + 4 * DFF + ci), b4 = *(const f32x4*)(cb + ci);
                    y[hf] = (r == 0) ? (w0 * um2 + w1 * um1 + w2 * u0 + b4) : (w0 * um1 + w1 * u0 + w2 * u1 + b4); }
                float o[4];
#pragma unroll
                for (int e = 0; e < 4; ++e) { const float gq = y[0][e]; o[e] = gq / (1.f + expf(-gq)) * y[1][e]; }
                u32x2 w; w.x = pk2(o[0], o[1]); w.y = pk2(o[2], o[3]); *(u32x2*)(act_ + (size_t)(pm * 256 + r) * DFF + c4) = w; }
        }
        GBAR();
        DUP(7) if (ON(13)) { pg8::Gemm g{Actb, Wdn + (size_t)l * DM * DFF, M, DM, DFF}; pg8::StaticOrder S; S.init(M, DM, G, bid);
          pg8::EpiZ E{ptab, l, 1};
          pg8::gemm_phase<pg8::EpiZ, pg8::StaticOrder, true, true>((LAS unsigned char*)lds, g, S, E); }
        GBAR();
        DUP(1) if (!ON(14)) {} else if (l == 0) { LN_PHASE(ln_ffn_g, ln_ffn_b, mod + (size_t)8 * 12288, mod + (size_t)8 * 12288 + 2048, true, false); GBAR(); }
        else { LN_PHASE(ln_ffn_g + DM, ln_ffn_b + DM, mod, mod, false, true); }
    }
}

extern "C" void kernel_launch(void* const* d_in, const int* in_sizes, int n_in, void* d_out, int out_size, void* d_ws, size_t ws_size, hipStream_t stream) {
    static int grid = 0;
    if (grid == 0) {
        if (n_in != 19 || out_size != M * DM || ws_size < WS_END) { fprintf(stderr, "kernel_launch: unexpected shapes (n_in %d out %d ws %zu)\n", n_in, out_size, ws_size); grid = -1; return; }
        int dev = 0, cus = 0, per_cu = 0;
        (void)hipGetDevice(&dev); (void)hipDeviceGetAttribute(&cus, hipDeviceAttributeMultiprocessorCount, dev);
        if (hipFuncSetAttribute((const void*)fwd_kernel, hipFuncAttributeMaxDynamicSharedMemorySize, LDS_BYTES) != hipSuccess) { fprintf(stderr, "kernel_launch: hipFuncSetAttribute failed\n"); grid = -1; return; }
        if (hipOccupancyMaxActiveBlocksPerMultiprocessor(&per_cu, (const void*)fwd_kernel, 512, LDS_BYTES) != hipSuccess || per_cu < 1) { fprintf(stderr, "kernel_launch: occupancy query says %d\n", per_cu); per_cu = 1; }
        (void)hipGetLastError();
        if (cus != 256) fprintf(stderr, "kernel_launch: %d CUs (built for 256)\n", cus);
        grid = 256;
    }
    if (grid < 0) return;
    if (hipMemsetAsync(d_ws, 0, 16384, stream) != hipSuccess) { fprintf(stderr, "kernel_launch: memset failed\n"); return; }
    Args a{};
    for (int i = 0; i < 19; ++i) a.in[i] = d_in[i];
    a.out = (float*)d_out; a.ws = (unsigned char*)d_ws;
    void* params[] = {&a};
    const hipError_t e = hipLaunchCooperativeKernel((const void*)fwd_kernel, dim3(grid), dim3(512), params, LDS_BYTES, stream);
    if (e != hipSuccess) fprintf(stderr, "kernel_launch: cooperative launch failed: %s\n", hipGetErrorString(e));
}
```

```cpp
#include <hip/hip_runtime.h>
#include <hip/hip_cooperative_groups.h>
#include <cstdio>
#include <cstdint>
#include <cmath>
namespace cg = cooperative_groups;
typedef __attribute__((address_space(3))) unsigned long long* ptab_t;
__device__ __forceinline__ const void* ldp(ptab_t ptab, int i) { const unsigned long long v = ptab[i];
    const unsigned lo = __builtin_amdgcn_readfirstlane((unsigned)v), hi = __builtin_amdgcn_readfirstlane((unsigned)(v >> 32)); return (const void*)(const __attribute__((address_space(1))) void*)(((unsigned long long)hi << 32) | lo); }
constexpr size_t WSO_MOD = (size_t)1 << 20, WSO_STATS = ((size_t)1 << 20) + 786432, WSO_Z = (size_t)264 << 20, WSO_UBUF = (size_t)4 << 20, WSO_Q = (size_t)392 << 20;
__device__ __forceinline__ int opaque_tid() { int t = threadIdx.x; asm volatile("" : "+v"(t)); return t & 511; }
namespace pg8 {
#define PG8_LAS __attribute__((address_space(3)))
typedef unsigned short bf16_t;
typedef short bf16x8 __attribute__((ext_vector_type(8)));
typedef float f32x4 __attribute__((ext_vector_type(4)));
typedef unsigned u32x4 __attribute__((ext_vector_type(4)));
typedef unsigned u32x2 __attribute__((ext_vector_type(2)));
constexpr int BM = 256, BK = 64, HALF = 128, HTB = HALF * BK * 2  , STAGE_BYTES = 8 * HTB, NXCD = 8, WGM = 8;

__host__ __device__ __forceinline__ int lds_byte(int r, int c) { const int st = (r >> 4) * 2 + (c >> 5), rr = r & 15, cc = c & 31, ob = rr * 64 + cc * 2; return st * 1024 + (ob ^ (((ob >> 9) & 1) << 5)); }
__host__ __device__ __forceinline__ void stage_rc(int b, int& R, int& C) { const int st = b / 1024, sb = b % 1024, swz = sb ^ (((sb >> 9) & 1) << 5); R = (st >> 1) * 16 + swz / 64; C = (st & 1) * 32 + (swz % 64) / 2; }
__host__ __device__ __forceinline__ int perm32(int rho) { const int n = rho >> 4, i = rho & 15; return 8 * (i >> 2) + 4 * n + (i & 3); }

struct Unit { int pm, pn; };
struct Gemm { const bf16_t* A; const bf16_t* Bt; int M, N, K; };

struct StaticOrder {
    int nM, nN, nwg, G, c;
    __host__ __device__ void init(int M, int N, int G_, int c_) { nM = M / BM; nN = N / BM; nwg = nM * nN; G = G_; c = c_; }
    __host__ __device__ bool next(int i, Unit& u) const {
        const long L = (long)i * G + c; if (L >= nwg) return false;
        int wgid = (int)L; { const int q = nwg / NXCD, r = nwg % NXCD, xcd = wgid % NXCD, off = wgid / NXCD; wgid = (xcd < r ? xcd * (q + 1) : r * (q + 1) + (xcd - r) * q) + off; }
        const int nig = WGM * nN, gid = wgid / nig, fm = gid * WGM, gsz = (nM - fm) < WGM ? (nM - fm) : WGM;
        u.pm = fm + ((wgid % nig) % gsz); u.pn = (wgid % nig) / gsz; return true;
    }
    __device__ __forceinline__ void a_ready(const Unit&) const {}
    __device__ __forceinline__ void done(const Unit&) const {}
};

__device__ __forceinline__ unsigned cvt_pk_bf16(float lo, float hi) { unsigned r; asm volatile("v_cvt_pk_bf16_f32 %0, %1, %2" : "=v"(r) : "v"(lo), "v"(hi)); return r; }
struct EpiBf16 {
    static constexpr bool PERM = true, AFTER_DRAIN = false;
    ptab_t ptab; int ldc; int split_cols; size_t split_stride;
    __device__ __forceinline__ void operator()(const f32x4 (&acc)[2][2][4][2], const Unit& u, int wr, int wc, int fr, int fq) const {
        bf16_t* O = (bf16_t*)((unsigned char*)ldp(ptab, 20) + WSO_Q);
        const int row0 = u.pm * BM + wr * 64 + fr; int colt = u.pn * BM; bf16_t* base = O;
        if (split_cols) { const int t = colt / split_cols; base += (size_t)t * split_stride; colt -= t * split_cols; }
        const int col0 = colt + wc * 32 + 8 * fq;
#pragma unroll
        for (int ai = 0; ai < 2; ++ai)
#pragma unroll
            for (int m = 0; m < 4; ++m) { bf16_t* rowp = base + (size_t)(row0 + ai * HALF + m * 16) * ldc + col0;
#pragma unroll
                for (int bj = 0; bj < 2; ++bj) { const f32x4 v0 = acc[ai][bj][m][0], v1 = acc[ai][bj][m][1];
                    u32x4 w; w.x = cvt_pk_bf16(v0[0], v0[1]); w.y = cvt_pk_bf16(v0[2], v0[3]); w.z = cvt_pk_bf16(v1[0], v1[1]); w.w = cvt_pk_bf16(v1[2], v1[3]);
                    *(u32x4*)(rowp + bj * HALF) = w; } }
    }
};
struct EpiZ {
    static constexpr bool PERM = false, AFTER_DRAIN = false;
    ptab_t ptab; int l, sub;
    __device__ __forceinline__ void operator()(const f32x4 (&acc)[2][2][4][2], const Unit& u, int wr, int wc, int fr, int fq) const {
        constexpr float alpha = 1.4142135623730951f;
        unsigned char* wsp = (unsigned char*)ldp(ptab, 20);
        float* z = (float*)(wsp + WSO_Z); const float* gate = (const float*)(wsp + WSO_MOD) + (size_t)l * 8 * 12288 + (sub ? 5 : 2) * 2048;
        const float* xres = (const float*)ldp(ptab, 0); const float* stats = (sub == 0 && l == 0) ? nullptr : (const float*)(wsp + WSO_STATS);
        const float* lg = sub ? (const float*)ldp(ptab, 15) + l * 2048 : (const float*)ldp(ptab, 17); const float* lb = sub ? (const float*)ldp(ptab, 16) + l * 2048 : (const float*)ldp(ptab, 18);
        const float* gv = gate + (size_t)(u.pm >> 3) * 12288;
        const int col0 = u.pn * BM + wc * 32 + 4 * fq;
        f32x4 g[2][2];
#pragma unroll
        for (int bj = 0; bj < 2; ++bj)
#pragma unroll
            for (int n = 0; n < 2; ++n) g[bj][n] = *(const f32x4*)(gv + col0 + bj * HALF + n * 16) + 1.0f;
        if (stats == nullptr) {
#pragma unroll
            for (int ai = 0; ai < 2; ++ai)
#pragma unroll
                for (int m = 0; m < 4; ++m) { const size_t off = (size_t)(u.pm * BM + ai * HALF + wr * 64 + m * 16 + fr) * 2048 + col0;
#pragma unroll
                    for (int bj = 0; bj < 2; ++bj)
#pragma unroll
                        for (int n = 0; n < 2; ++n) { const f32x4 xr = *(const f32x4*)(xres + off + bj * HALF + n * 16);
                            *(f32x4*)(z + off + bj * HALF + n * 16) = xr * alpha + g[bj][n] * acc[ai][bj][m][n]; }
                    asm volatile("" ::: "memory"); }
        } else {
            f32x4 wg[2][2], wb[2][2];
#pragma unroll
            for (int bj = 0; bj < 2; ++bj)
#pragma unroll
                for (int n = 0; n < 2; ++n) { wg[bj][n] = *(const f32x4*)(lg + col0 + bj * HALF + n * 16) * alpha; wb[bj][n] = *(const f32x4*)(lb + col0 + bj * HALF + n * 16) * alpha; }
#pragma unroll
            for (int ai = 0; ai < 2; ++ai)
#pragma unroll
                for (int m = 0; m < 4; ++m) { const int row = u.pm * BM + ai * HALF + wr * 64 + m * 16 + fr; const size_t off = (size_t)row * 2048 + col0;
                    const float mean = stats[2 * row], rstd = stats[2 * row + 1];
#pragma unroll
                    for (int bj = 0; bj < 2; ++bj)
#pragma unroll
                        for (int n = 0; n < 2; ++n) { const f32x4 zo = *(const f32x4*)(z + off + bj * HALF + n * 16);
                            *(f32x4*)(z + off + bj * HALF + n * 16) = ((zo - mean) * rstd) * wg[bj][n] + wb[bj][n] + g[bj][n] * acc[ai][bj][m][n]; }
                    asm volatile("" ::: "memory"); }
        }
    }
};
__device__ __forceinline__ float dpp_ror1(float v) { return __builtin_bit_cast(float, __builtin_amdgcn_update_dpp(0, __builtin_bit_cast(int, v), 0x121, 0xf, 0xf, false)); }
__device__ __forceinline__ float dpp_ror2(float v) { return __builtin_bit_cast(float, __builtin_amdgcn_update_dpp(0, __builtin_bit_cast(int, v), 0x122, 0xf, 0xf, false)); }
struct EpiUp {
    static constexpr bool PERM = true, AFTER_DRAIN = false;
    ptab_t ptab; int l; PG8_LAS unsigned char* halo;
    __device__ __forceinline__ void operator()(const f32x4 (&acc)[2][2][4][2], const Unit& u, int wr, int wc, int fr, int fq) const {
        unsigned char* wsp = (unsigned char*)ldp(ptab, 20);
        bf16_t* act = (bf16_t*)(wsp + WSO_Q); float* ubuf = (float*)(wsp + WSO_UBUF);
        const float* cw = (const float*)ldp(ptab, 12) + (size_t)l * 3 * 11264; const float* cb = (const float*)ldp(ptab, 13) + (size_t)l * 11264;
        const int tcol = wc * 32 + 8 * fq;
        const int ch0 = u.pn * 128 + tcol;
        if (fr >= 14) {
#pragma unroll
            for (int ai = 0; ai < 2; ++ai) { const int blk = 2 * ai + wr;
                if (blk < 3) {
#pragma unroll
                    for (int bj = 0; bj < 2; ++bj)
#pragma unroll
                        for (int n = 0; n < 2; ++n) *(PG8_LAS f32x4*)(halo + (size_t)(((blk * 2 + (fr - 14)) * 256) + bj * 128 + tcol + 4 * n) * 4) = acc[ai][bj][3][n];
                } }
            if (wr == 1) {
#pragma unroll
                for (int bj = 0; bj < 2; ++bj)
#pragma unroll
                    for (int n = 0; n < 2; ++n) *(f32x4*)(ubuf + ((size_t)((u.pm * 4 + 2 + (fr - 14)) * 2 + bj)) * 5632 + ch0 + 4 * n) = acc[1][bj][3][n];
            }
        }
        if (wr == 0 && fr < 2) {
#pragma unroll
            for (int bj = 0; bj < 2; ++bj)
#pragma unroll
                for (int n = 0; n < 2; ++n) *(f32x4*)(ubuf + ((size_t)((u.pm * 4 + fr) * 2 + bj)) * 5632 + ch0 + 4 * n) = acc[0][bj][0][n];
        }
        asm volatile("s_waitcnt lgkmcnt(0)" ::: "memory"); __builtin_amdgcn_s_barrier(); asm volatile("" ::: "memory");
        const bool f1 = fr >= 1, f2 = fr >= 2;
#pragma unroll
        for (int n = 0; n < 2; ++n) {
            f32x4 w0[2], w1[2], w2[2], bb[2];
#pragma unroll
            for (int bj = 0; bj < 2; ++bj) { const int ci = bj * 5632 + ch0 + 4 * n;
                w0[bj] = *(const f32x4*)(cw + ci); w1[bj] = *(const f32x4*)(cw + 11264 + ci); w2[bj] = *(const f32x4*)(cw + 22528 + ci); bb[bj] = *(const f32x4*)(cb + ci); }
#pragma unroll
            for (int ai = 0; ai < 2; ++ai) { const int blk = 2 * ai + wr;
                f32x4 H[2];
#pragma unroll
                for (int bj = 0; bj < 2; ++bj) { H[bj] = (f32x4){0.f, 0.f, 0.f, 0.f};
                    if (blk > 0 && fr >= 14) H[bj] = *(const PG8_LAS f32x4*)(halo + (size_t)((((blk - 1) * 2 + (fr - 14)) * 256) + bj * 128 + tcol + 4 * n) * 4); }
#pragma unroll
                for (int m = 0; m < 4; ++m) {
                    f32x4 y[2];
#pragma unroll
                    for (int bj = 0; bj < 2; ++bj) { const f32x4 cur = acc[ai][bj][m][n]; f32x4 prv; if (m == 0) prv = H[bj]; else prv = acc[ai][bj][m > 0 ? m - 1 : 0][n];
#pragma unroll
                        for (int e = 0; e < 4; ++e) { const float c1 = dpp_ror1(cur[e]), p1 = dpp_ror1(prv[e]), c2 = dpp_ror2(cur[e]), p2 = dpp_ror2(prv[e]);
                            const float a1 = f1 ? c1 : p1, a2 = f2 ? c2 : p2;
                            y[bj][e] = fmaf(w2[bj][e], cur[e], fmaf(w1[bj][e], a1, fmaf(w0[bj][e], a2, bb[bj][e]))); } }
                    float o[4];
#pragma unroll
                    for (int e = 0; e < 4; ++e) { const float g = y[0][e]; const float sg = g * __builtin_amdgcn_rcpf(1.0f + __builtin_amdgcn_exp2f(-1.4426950408889634f * g)); o[e] = sg * y[1][e]; }
                    u32x2 w; w.x = cvt_pk_bf16(o[0], o[1]); w.y = cvt_pk_bf16(o[2], o[3]);
                    *(u32x2*)(act + (size_t)(u.pm * BM + ai * HALF + wr * 64 + m * 16 + fr) * 5632 + ch0 + 4 * n) = w;
                }
            }
            asm volatile("" ::: "memory");
        }
    }
};
template <class Epi, class Sched, bool ALIGN_EPI = false, bool SP2 = false>
__device__ __forceinline__ void gemm_phase(PG8_LAS unsigned char* lds, const Gemm g, const Sched& S, const Epi& E) {
    const int tid = opaque_tid(), wid = __builtin_amdgcn_readfirstlane(tid >> 6), lane = tid & 63, wr = wid >> 2, wc = wid & 3, fr = lane & 15, fq = lane >> 4;
    const int K = g.K, nt = K / BK;
    unsigned voffA[2], voffB[2];
#pragma unroll
    for (int i = 0; i < 2; ++i) { int R, C; stage_rc(tid * 16 + i * 8192, R, C); const int Rb = Epi::PERM ? ((R & ~31) + perm32(R & 31)) : R;
        voffA[i] = (unsigned)(R * K + C) * 2u; voffB[i] = (unsigned)(Rb * K + C) * 2u; }
    const size_t kstep = (size_t)(BK * 2);
    const size_t hstep = (size_t)HALF * K * 2;
    const size_t tstep = 2 * hstep;
    const unsigned ldsw = (unsigned)wid * 1024u;
    const int aoff = lds_byte(wr * 64 + fr, fq * 8), boff = lds_byte(wc * 32 + fr, fq * 8);
#define PG8_SA(b, h) (((b) * 2 + (h)) * HTB)
#define PG8_SB(b, h) ((4 + (b) * 2 + (h)) * HTB)
#define PG8_STAGE(bufoff, gbase, voff) do { _Pragma("unroll") for (int _i = 0; _i < 2; ++_i) \
        __builtin_amdgcn_global_load_lds((const unsigned*)((const char*)(gbase) + (voff)[_i]), (PG8_LAS unsigned*)(lds + (bufoff) + ldsw + _i * 8192), 16, 0, 0); } while (0)
#define PG8_LDA(dst, b, h) do { _Pragma("unroll") for (int m = 0; m < 4; ++m) _Pragma("unroll") for (int k = 0; k < 2; ++k) dst[m][k] = *(const PG8_LAS bf16x8*)(lds + PG8_SA(b, h) + aoff + m * 2048 + k * 1024); } while (0)
#define PG8_LDB(dst, b, h) do { _Pragma("unroll") for (int n = 0; n < 2; ++n) _Pragma("unroll") for (int k = 0; k < 2; ++k) dst[n][k] = *(const PG8_LAS bf16x8*)(lds + PG8_SB(b, h) + boff + n * 2048 + k * 1024); } while (0)
#define PG8_MMA(ai, bj, At, Bt) do { __builtin_amdgcn_s_setprio(1); _Pragma("unroll") for (int m = 0; m < 4; ++m) _Pragma("unroll") for (int n = 0; n < 2; ++n) _Pragma("unroll") for (int k = 0; k < 2; ++k) \
        acc[ai][bj][m][n] = __builtin_amdgcn_mfma_f32_16x16x32_bf16(Bt[n][k], At[m][k], acc[ai][bj][m][n], 0, 0, 0); __builtin_amdgcn_s_setprio(0); } while (0)
#define PG8_WAIT_V(n) asm volatile("s_waitcnt vmcnt(" #n ")" ::: "memory")
#define PG8_WAIT_L(n) asm volatile("s_waitcnt lgkmcnt(" #n ")" ::: "memory")
#define PG8_BAR __builtin_amdgcn_s_barrier()
#define PG8_SCHED __builtin_amdgcn_sched_barrier(0)
    Unit cur, nxt; int ui = 0;
    if (!S.next(0, cur)) return;
    f32x4 acc[2][2][4][2];
#pragma unroll
    for (int a = 0; a < 2; ++a)
#pragma unroll
        for (int b = 0; b < 2; ++b)
#pragma unroll
            for (int m = 0; m < 4; ++m)
#pragma unroll
                for (int n = 0; n < 2; ++n) acc[a][b][m][n] = (f32x4){0.f, 0.f, 0.f, 0.f};
    bf16x8 At[4][2], B0[2][2], B1[2][2];
    const char* cA = (const char*)g.A + (size_t)cur.pm * tstep; const char* cB = (const char*)g.Bt + (size_t)cur.pn * tstep;
    S.a_ready(cur);
    if constexpr (SP2) {
        PG8_STAGE(PG8_SB(0, 0), cB, voffB); PG8_STAGE(PG8_SB(0, 1), cB + hstep, voffB); PG8_STAGE(PG8_SA(0, 0), cA, voffA); PG8_STAGE(PG8_SA(0, 1), cA + hstep, voffA);
        if (wr == 1) PG8_BAR;
        PG8_WAIT_V(2); PG8_BAR;
        PG8_STAGE(PG8_SB(1, 0), cB + kstep, voffB); PG8_STAGE(PG8_SA(1, 0), cA + kstep, voffA); PG8_STAGE(PG8_SB(1, 1), cB + hstep + kstep, voffB);
        PG8_WAIT_V(6); PG8_BAR;
    } else {
        PG8_STAGE(PG8_SB(0, 0), cB, voffB); PG8_STAGE(PG8_SA(0, 0), cA, voffA); PG8_STAGE(PG8_SB(0, 1), cB + hstep, voffB); PG8_STAGE(PG8_SA(0, 1), cA + hstep, voffA);
        if (wr == 1) PG8_BAR;
        PG8_WAIT_V(4); PG8_BAR;
        PG8_STAGE(PG8_SB(1, 0), cB + kstep, voffB); PG8_STAGE(PG8_SA(1, 0), cA + kstep, voffA); PG8_STAGE(PG8_SB(1, 1), cB + hstep + kstep, voffB);
        PG8_WAIT_V(6); PG8_BAR;
    }
    for (;;) {
        const bool has_next = S.next(ui + 1, nxt);
        const char* nA = has_next ? (const char*)g.A + (size_t)nxt.pm * tstep : cA; const char* nB = has_next ? (const char*)g.Bt + (size_t)nxt.pn * tstep : cB;
        for (int t = 0; t < nt; t += 2) {
            const bool last = (t == nt - 2);
            const char* a1 = cA + (size_t)(t + 1) * kstep;
            const char* a2 = last ? nA : cA + (size_t)(t + 2) * kstep; const char* b2 = last ? nB : cB + (size_t)(t + 2) * kstep;
            const char* a3 = a2 + kstep; const char* b3 = b2 + kstep;
            if (last && has_next) S.a_ready(nxt);
            if constexpr (SP2) {
            PG8_LDB(B0, 0, 0); PG8_LDB(B1, 0, 1); PG8_SCHED; PG8_LDA(At, 0, 0); PG8_STAGE(PG8_SA(1, 1), a1 + hstep, voffA);
            PG8_WAIT_V(8); PG8_WAIT_L(0); PG8_BAR; PG8_MMA(0, 0, At, B0); PG8_MMA(0, 1, At, B1); PG8_BAR; PG8_SCHED;
            PG8_LDA(At, 0, 1); PG8_STAGE(PG8_SB(0, 0), b2, voffB); PG8_STAGE(PG8_SB(0, 1), b2 + hstep, voffB); PG8_STAGE(PG8_SA(0, 0), a2, voffA);
            PG8_WAIT_V(8); PG8_WAIT_L(0); PG8_BAR; PG8_MMA(1, 0, At, B0); PG8_MMA(1, 1, At, B1); PG8_BAR; PG8_SCHED;
            PG8_LDB(B0, 1, 0); PG8_LDB(B1, 1, 1); PG8_SCHED; PG8_LDA(At, 1, 0); PG8_STAGE(PG8_SA(0, 1), a2 + hstep, voffA);
            PG8_WAIT_V(8); PG8_WAIT_L(0); PG8_BAR; PG8_MMA(0, 0, At, B0); PG8_MMA(0, 1, At, B1); PG8_BAR; PG8_SCHED;
            PG8_LDA(At, 1, 1); PG8_STAGE(PG8_SB(1, 0), b3, voffB); PG8_STAGE(PG8_SB(1, 1), b3 + hstep, voffB); PG8_STAGE(PG8_SA(1, 0), a3, voffA);
            PG8_WAIT_V(8); PG8_WAIT_L(0); PG8_BAR; PG8_MMA(1, 0, At, B0); PG8_MMA(1, 1, At, B1); PG8_BAR; PG8_SCHED;
            } else {
            PG8_LDB(B0, 0, 0); PG8_SCHED; PG8_LDA(At, 0, 0); PG8_STAGE(PG8_SA(1, 1), a1 + hstep, voffA);
            PG8_WAIT_L(8); PG8_BAR; PG8_WAIT_L(0); PG8_MMA(0, 0, At, B0); PG8_BAR; PG8_SCHED;
            PG8_LDB(B1, 0, 1); PG8_STAGE(PG8_SB(0, 0), b2, voffB);
            PG8_BAR; PG8_WAIT_L(0); PG8_MMA(0, 1, At, B1); PG8_BAR;
            PG8_LDA(At, 0, 1); PG8_STAGE(PG8_SA(0, 0), a2, voffA);
            PG8_BAR; PG8_WAIT_L(0); PG8_MMA(1, 0, At, B0); PG8_BAR; PG8_SCHED;
            PG8_STAGE(PG8_SB(0, 1), b2 + hstep, voffB);
            PG8_WAIT_V(6); PG8_BAR; PG8_MMA(1, 1, At, B1); PG8_BAR;
            PG8_LDB(B0, 1, 0); PG8_SCHED; PG8_LDA(At, 1, 0); PG8_STAGE(PG8_SA(0, 1), a2 + hstep, voffA);
            PG8_WAIT_L(8); PG8_BAR; PG8_WAIT_L(0); PG8_MMA(0, 0, At, B0); PG8_BAR; PG8_SCHED;
            PG8_LDB(B1, 1, 1); PG8_STAGE(PG8_SB(1, 0), b3, voffB);
            PG8_BAR; PG8_WAIT_L(0); PG8_MMA(0, 1, At, B1); PG8_BAR;
            PG8_LDA(At, 1, 1); PG8_STAGE(PG8_SA(1, 0), a3, voffA);
            PG8_BAR; PG8_WAIT_L(0); PG8_MMA(1, 0, At, B0); PG8_BAR; PG8_SCHED;
            PG8_STAGE(PG8_SB(1, 1), b3 + hstep, voffB);
            PG8_WAIT_V(6); PG8_BAR; PG8_MMA(1, 1, At, B1); PG8_BAR;
            }
        }
        if constexpr (ALIGN_EPI) { if (wr == 0) PG8_BAR; }
        if constexpr (!Epi::AFTER_DRAIN) { E(acc, cur, wr, wc, fr, fq); S.done(cur); }
        if (!has_next) break;
#pragma unroll
        for (int a = 0; a < 2; ++a)
#pragma unroll
            for (int b = 0; b < 2; ++b)
#pragma unroll
                for (int m = 0; m < 4; ++m)
#pragma unroll
                    for (int n = 0; n < 2; ++n) acc[a][b][m][n] = (f32x4){0.f, 0.f, 0.f, 0.f};
        cur = nxt; cA = nA; cB = nB; ++ui;
        if constexpr (ALIGN_EPI) { if (wr == 1) PG8_BAR; }
    }
    PG8_WAIT_V(0);
    if constexpr (!ALIGN_EPI) { if (wr == 0) PG8_BAR; }
    PG8_BAR;
    if constexpr (Epi::AFTER_DRAIN) { E.fused(acc, cur, wr, wc, fr, fq, lds, wid, lane); S.done(cur); }
#undef PG8_SA
#undef PG8_SB
#undef PG8_STAGE
#undef PG8_LDA
#undef PG8_LDB
#undef PG8_MMA
#undef PG8_WAIT_V
#undef PG8_WAIT_L
#undef PG8_BAR
#undef PG8_SCHED
}
}
namespace fox {
typedef unsigned short bf16;
typedef short bf16x8 __attribute__((ext_vector_type(8)));
typedef short s16x4 __attribute__((ext_vector_type(4)));
typedef float f32x16 __attribute__((ext_vector_type(16)));
typedef float f32x4 __attribute__((ext_vector_type(4)));
typedef unsigned u32x4 __attribute__((ext_vector_type(4)));
#define FLAS __attribute__((address_space(3)))
constexpr int D = 128, PITCH = 2048, SEQ = 2048;
constexpr float SCALE = 0.08838834764831845f, INV_SCALE = 11.313708498984761f, THR = 8.f;
constexpr int NW = 8, QBLK = 32, KVBLK = 64, QB = NW * QBLK;
constexpr int SHM_V = KVBLK * D * 2, SHM_K = KVBLK * D * 2;
constexpr int LDS_WS = 2 * SHM_V + 2 * SHM_K, LDS_KB = LDS_WS + NW * 64 * 4, LDS_WT = LDS_KB + 4 * SEQ * 4, LDS_BYTES = LDS_WT + 64;
constexpr int WBIG = 1 << 30;
#define KSWZ(row, colB) ((row) * 256 + ((colB) ^ (((row) & 7) << 4)))
#define SBAR() __builtin_amdgcn_sched_barrier(0)
__device__ __forceinline__ int v_st(int k, int c) { const int kk = (k & ~0xC) | ((k & 4) << 1) | ((k & 8) >> 1); return ((kk >> 3) * 4 + (c >> 5)) * 512 + ((kk & 7) * 32 + (c & 31)) * 2; }
__device__ __forceinline__ int v_rd_base(int lane) { return ((lane & 3) << 3) | (((lane >> 2) & 3) << 6) | (((lane >> 4) & 1) << 5) | (((lane >> 5) & 1) << 8); }
constexpr int v_rd_off(int d0, int ks, int half) { return d0 * 512 + ks * 4096 + half * 2048; }
__device__ __forceinline__ int crow(int r, int hi) { return (r & 3) + 8 * (r >> 2) + 4 * hi; }
__device__ __forceinline__ unsigned cvtpk(float lo, float hi) { unsigned r; asm volatile("v_cvt_pk_bf16_f32 %0, %1, %2" : "=v"(r) : "v"(lo), "v"(hi)); return r; }
__device__ __forceinline__ bf16x8 load8(const bf16* p) { return *reinterpret_cast<const bf16x8*>(p); }
__device__ __forceinline__ void mask_tile(f32x16& p0, f32x16& p1, int dq, unsigned W) {
    const float NEG = -__builtin_inff();
#pragma unroll
    for (int r = 0; r < 16; ++r) {
        const int c = (r & 3) + 8 * (r >> 2);
        if ((unsigned)(dq - c) >= W) p0[r] = NEG;
        if ((unsigned)(dq - c - 32) >= W) p1[r] = NEG;
    }
}
__device__ __forceinline__ void partialSM(f32x16& p0, f32x16& p1, float& m_reg, float& mn, float& alpha) {
    float pmax = p0[0];
#pragma unroll
    for (int r = 1; r < 16; ++r) pmax = fmaxf(pmax, p0[r]);
#pragma unroll
    for (int r = 0; r < 16; ++r) pmax = fmaxf(pmax, p1[r]);
    { auto rr = __builtin_amdgcn_permlane32_swap(__float_as_uint(pmax), __float_as_uint(pmax), false, false);
      pmax = fmaxf(__uint_as_float(rr[0]), __uint_as_float(rr[1])); }
    constexpr float C2 = 1.4426950408889634f * SCALE;
    if (__builtin_expect(__all((pmax - m_reg) * SCALE <= THR), 1)) { mn = m_reg; alpha = 1.f; }
    else { mn = fmaxf(m_reg, pmax); alpha = __builtin_amdgcn_exp2f((m_reg - mn) * C2); m_reg = mn; }
    const float mnL = -mn * C2;
#pragma unroll
    for (int r = 0; r < 16; ++r) p0[r] = fmaf(p0[r], C2, mnL);
#pragma unroll
    for (int r = 0; r < 16; ++r) p1[r] = fmaf(p1[r], C2, mnL);
#pragma unroll
    for (int r = 0; r < 16; ++r) p0[r] = __builtin_amdgcn_exp2f(p0[r]);
}
#define PK4(P, B_, OUT) do { unsigned a0 = cvtpk(P[B_+0], P[B_+1]), a1 = cvtpk(P[B_+2], P[B_+3]);                          \
        unsigned b0 = cvtpk(P[B_+4], P[B_+5]), b1 = cvtpk(P[B_+6], P[B_+7]);                                             \
        auto r0 = __builtin_amdgcn_permlane32_swap(a0, b0, false, false); auto r1 = __builtin_amdgcn_permlane32_swap(a1, b1, false, false); \
        u32x4 w = {r0[0], r1[0], r0[1], r1[1]}; OUT = *reinterpret_cast<bf16x8*>(&w); } while (0)
__device__ __forceinline__ void finishSM(f32x16& p0, f32x16& p1, float alpha, float& l_reg, bf16x8& pa0, bf16x8& pa1, bf16x8& pa2, bf16x8& pa3) {
#pragma unroll
    for (int r = 0; r < 16; ++r) p1[r] = __builtin_amdgcn_exp2f(p1[r]);
    float ps = 0;
#pragma unroll
    for (int r = 0; r < 16; ++r) ps += p0[r];
#pragma unroll
    for (int r = 0; r < 16; ++r) ps += p1[r];
    { auto rr = __builtin_amdgcn_permlane32_swap(__float_as_uint(ps), __float_as_uint(ps), false, false);
      ps = __uint_as_float(rr[0]) + __uint_as_float(rr[1]); }
    l_reg = l_reg * alpha + ps;
    PK4(p0, 0, pa0); PK4(p0, 8, pa1); PK4(p1, 0, pa2); PK4(p1, 8, pa3);
}
template <int KB>
__device__ __forceinline__ void qkt(f32x16& p0, f32x16& p1, const char* K_lds, int r32, int hi, const bf16x8* qr, const FLAS float* kbp) {
#pragma unroll
    for (int g = 0; g < 4; ++g) { const f32x4 v0 = *(const FLAS f32x4*)(kbp + 8 * g), v1 = *(const FLAS f32x4*)(kbp + 32 + 8 * g);
#pragma unroll
        for (int e = 0; e < 4; ++e) { p0[4 * g + e] = v0[e]; p1[4 * g + e] = v1[e]; } }
    const char* kb[4];
#pragma unroll
    for (int dd = 0; dd < 4; ++dd) kb[dd] = K_lds + KB * SHM_K + KSWZ(r32, (dd * 16 + hi * 8) * 2);
#pragma unroll
    for (int d0 = 0; d0 < 8; ++d0) { const char* a = kb[d0 & 3] + (d0 >> 2) * 128;
        bf16x8 b0 = *reinterpret_cast<const bf16x8*>(a);
        bf16x8 b1 = *reinterpret_cast<const bf16x8*>(a + 32 * 256);
        p0 = __builtin_amdgcn_mfma_f32_32x32x16_bf16(b0, qr[d0], p0, 0, 0, 0);
        p1 = __builtin_amdgcn_mfma_f32_32x32x16_bf16(b1, qr[d0], p1, 0, 0, 0); }
}
template <int VB>
__device__ __forceinline__ void pv_tile(f32x16* o, int vb0, bf16x8 pa0, bf16x8 pa1, bf16x8 pa2, bf16x8 pa3) {
#define TRRD(dst, off) asm volatile("ds_read_b64_tr_b16 %0, %1 offset:%2" : "=&v"(dst) : "v"(vb0), "i"(off) : "memory")
#define PV_D0(d0) do { s16x4 l0, l1, l2, l3, h0, h1, h2, h3; constexpr int b_ = VB * SHM_V + v_rd_off(d0, 0, 0); \
        TRRD(l0, b_); TRRD(h0, b_ + 2048); TRRD(l1, b_ + 4096); TRRD(h1, b_ + 6144); TRRD(l2, b_ + 8192); TRRD(h2, b_ + 10240); TRRD(l3, b_ + 12288); TRRD(h3, b_ + 14336); \
        asm volatile("s_waitcnt lgkmcnt(0)" ::: "memory"); SBAR(); \
        o[d0] = __builtin_amdgcn_mfma_f32_32x32x16_bf16(pa0, (bf16x8){l0[0], l0[1], l0[2], l0[3], h0[0], h0[1], h0[2], h0[3]}, o[d0], 0, 0, 0);   \
        o[d0] = __builtin_amdgcn_mfma_f32_32x32x16_bf16(pa1, (bf16x8){l1[0], l1[1], l1[2], l1[3], h1[0], h1[1], h1[2], h1[3]}, o[d0], 0, 0, 0);   \
        o[d0] = __builtin_amdgcn_mfma_f32_32x32x16_bf16(pa2, (bf16x8){l2[0], l2[1], l2[2], l2[3], h2[0], h2[1], h2[2], h2[3]}, o[d0], 0, 0, 0);   \
        o[d0] = __builtin_amdgcn_mfma_f32_32x32x16_bf16(pa3, (bf16x8){l3[0], l3[1], l3[2], l3[3], h3[0], h3[1], h3[2], h3[3]}, o[d0], 0, 0, 0); } while (0)
    PV_D0(0); PV_D0(1); PV_D0(2); PV_D0(3);
#undef PV_D0
#undef TRRD
}
struct BlockRef { const bf16* Q; const bf16* K; const bf16* V; bf16* O; const float* lf; int P0; };
struct Seam { bf16x8 qr[8]; bf16x8 st_v0, st_v1, st_k0, st_k1; };
#define ROW(p, k0, rr) ((p) + (size_t)((k0) + (rr)) * PITCH + sc)
#define VMW() asm volatile("s_waitcnt vmcnt(0)" ::: "memory")
#define VMWN(n) asm volatile("s_waitcnt vmcnt(%0)" :: "i"(n) : "memory")
#define SLOAD_H(Kp, Vp, k0) do { const bf16* kq_ = (Kp) + (size_t)(k0) * PITCH; const bf16* vq_ = (Vp) + (size_t)(k0) * PITCH; \
                         S.st_v0 = load8(vq_ + soff); S.st_v1 = load8(vq_ + 32 * PITCH + soff); S.st_k0 = load8(kq_ + soff); S.st_k1 = load8(kq_ + 32 * PITCH + soff); } while (0)
#define SWRITE_HK(bf) do { *(bf16x8*)(K_lds + (bf) * SHM_K + kws) = S.st_k0; *(bf16x8*)(K_lds + (bf) * SHM_K + kws + 32 * 256) = S.st_k1; } while (0)
#define SWRITE_HV(bf) do { *(bf16x8*)(V_lds + (bf) * SHM_V + vst0) = S.st_v0; *(bf16x8*)(V_lds + (bf) * SHM_V + vst1) = S.st_v1; } while (0)
#define SWRITE_H(bf) do { SWRITE_HV(bf); SWRITE_HK(bf); } while (0)
__device__ __forceinline__ void prime(const BlockRef& cur, char* lds, Seam& S) {
    const int tid = opaque_tid(), wid = __builtin_amdgcn_readfirstlane(tid >> 6), lane = tid & 63, r32 = lane & 31, hi = lane >> 5;
    const int sr = tid >> 4, sc = (tid & 15) * 8, kws = KSWZ(sr, sc * 2); char* K_lds = lds + 2 * SHM_V; const unsigned soff = sr * PITCH + sc, qoff = r32 * PITCH + hi * 8;
    { const bf16* qb_ = cur.Q + (size_t)(wid * QBLK) * PITCH;
#pragma unroll
    for (int d0 = 0; d0 < 8; ++d0) S.qr[d0] = load8(qb_ + qoff + d0 * 16); }
    SLOAD_H(cur.K, cur.V, 0); VMW(); SWRITE_HK(0);
    __syncthreads();
}
__device__ __forceinline__ void key_bias(const BlockRef& cur, char* lds, int slot) {
    const int tid = opaque_tid(), wid = __builtin_amdgcn_readfirstlane(tid >> 6), lane = tid & 63;
    FLAS float* kb = (FLAS float*)(lds + LDS_KB) + slot * SEQ; FLAS float* wt = (FLAS float*)(lds + LDS_WT);
    const int n = cur.P0 + QB; const bool act = 4 * tid < n;
    float lf[4];
#pragma unroll
    for (int j = 0; j < 4; ++j) lf[j] = act ? cur.lf[(size_t)(4 * tid + j) * 16] : 0.f;
    lf[1] += lf[0]; lf[2] += lf[1]; lf[3] += lf[2];
    float tot = lf[3];
#pragma unroll
    for (int o = 1; o < 64; o <<= 1) { const float t = __shfl_up(tot, o); if (lane >= o) tot += t; }
    if (lane == 63) wt[wid] = tot;
    __syncthreads();
    float off = tot - lf[3];
#pragma unroll
    for (int w = 0; w < 8; ++w) { const float t = wt[w]; if (w < wid) off += t; }
    if (4 * tid == cur.P0) wt[8] = off + lf[0];
    __syncthreads();
    const float cref = wt[8];
    f32x4 o4; o4[0] = (cref - (off + lf[0])) * INV_SCALE; o4[1] = (cref - (off + lf[1])) * INV_SCALE; o4[2] = (cref - (off + lf[2])) * INV_SCALE; o4[3] = (cref - (off + lf[3])) * INV_SCALE;
    *(FLAS f32x4*)(kb + 4 * tid) = o4;
    __syncthreads();
}
__device__ __forceinline__ void block(const BlockRef& cur, const BlockRef& nxt, char* lds, Seam& S, int slot) {
    const int tid = opaque_tid(), wid = __builtin_amdgcn_readfirstlane(tid >> 6), lane = tid & 63, r32 = lane & 31, hi = lane >> 5;
    constexpr int W = WBIG;
    const int NT = (cur.P0 + QB - 1) / KVBLK + 1;
    const int qlo = cur.P0 + wid * QBLK, qm = qlo + r32 - 4 * hi;
    char* V_lds = lds; char* K_lds = lds + 2 * SHM_V;
    float* ws = (float*)(lds + LDS_WS) + wid * 64; float* li_l = ws, * al_l = ws + 32;
    const FLAS float* kbl = (const FLAS float*)(lds + LDS_KB) + slot * SEQ + 4 * hi;
    float m_reg = -1e30f, l_reg = 0; f32x16 o[4] = {};
    const int sr = tid >> 4, sc = (tid & 15) * 8, vst0 = v_st(sr, sc), vst1 = v_st(32 + sr, sc), kws = KSWZ(sr, sc * 2); const unsigned soff = sr * PITCH + sc, qoff = r32 * PITCH + hi * 8;
    const int vb0 = (int)(uintptr_t)V_lds + v_rd_base(lane);
    const bf16* Kh = cur.K; const bf16* Vh = cur.V;
#define RESC(a) do { if (__any((a) < 1.f)) { if (hi == 0) al_l[r32] = (a); asm volatile("s_waitcnt lgkmcnt(0)" ::: "memory");              \
                     for (int d_ = 0; d_ < 4; ++d_) for (int r = 0; r < 16; ++r) o[d_][r] *= al_l[crow(r, hi)]; } } while (0)
#define KBASE(t) ((t) * KVBLK)
#define MASKT(P0_, P1_, t) do { const int kb_ = KBASE(t); if (kb_ + KVBLK - 1 > qlo) mask_tile(P0_, P1_, qm - kb_, (unsigned)W); } while (0)
#define SEAM_K0() do { VMWN(8); SWRITE_HK(0); SBAR(); } while (0)
    f32x16 pA0, pA1, pB0, pB1; float mnA, mnB, alA, alB; bf16x8 pa0, pa1, pa2, pa3;
    SWRITE_HV(0); SBAR();
    if (NT > 1) { SLOAD_H(Kh, Vh, KBASE(1)); }
    SBAR(); qkt<0>(pA0, pA1, K_lds, r32, hi, S.qr, kbl + KBASE(0));
    MASKT(pA0, pA1, 0); partialSM(pA0, pA1, m_reg, mnA, alA);
    if (NT > 1) { VMW(); SWRITE_H(1); }
    __syncthreads();
#define HALF_STEP(PX0, PX1, mnX, alX, PY0, PY1, alY, t, KB, VB, SB) do {                                                      \
        SBAR(); qkt<KB>(PX0, PX1, K_lds, r32, hi, S.qr, kbl + KBASE(t));                                                          \
        finishSM(PY0, PY1, alY, l_reg, pa0, pa1, pa2, pa3); SBAR();                                                           \
        if ((t) + 1 < NT) { SLOAD_H(Kh, Vh, KBASE((t) + 1)); SBAR(); }                                               \
        pv_tile<VB>(o, vb0, pa0, pa1, pa2, pa3); MASKT(PX0, PX1, (t)); partialSM(PX0, PX1, m_reg, mnX, alX);   \
        __syncthreads();                                                                                                      \
        if ((t) + 1 < NT) { VMW(); SWRITE_H(SB); }                                                                          \
        RESC(alX); __syncthreads(); } while (0)
    for (int t = 1; t + 1 < NT; t += 2) {
        HALF_STEP(pB0, pB1, mnB, alB, pA0, pA1, alA, t, 1, 0, 0);
        HALF_STEP(pA0, pA1, mnA, alA, pB0, pB1, alB, t + 1, 0, 1, 1);
    }
    const bool even = (NT & 1) == 0;
    if (even) { SBAR(); qkt<1>(pB0, pB1, K_lds, r32, hi, S.qr, kbl + KBASE(NT - 1)); SBAR(); }
    SLOAD_H(nxt.K, nxt.V, 0); SBAR();
    { const bf16* qb_ = nxt.Q + (size_t)(wid * QBLK) * PITCH;
#pragma unroll
    for (int d0 = 0; d0 < 8; ++d0) S.qr[d0] = load8(qb_ + qoff + d0 * 16); }
    SBAR();
    finishSM(pA0, pA1, alA, l_reg, pa0, pa1, pa2, pa3); SBAR();
    pv_tile<0>(o, vb0, pa0, pa1, pa2, pa3);
    if (even) { MASKT(pB0, pB1, NT - 1); partialSM(pB0, pB1, m_reg, mnB, alB); __syncthreads(); RESC(alB);
        finishSM(pB0, pB1, alB, l_reg, pa0, pa1, pa2, pa3); SBAR(); pv_tile<1>(o, vb0, pa0, pa1, pa2, pa3); }
    SBAR(); SEAM_K0();
    if (hi == 0) li_l[r32] = l_reg; asm volatile("s_waitcnt lgkmcnt(0)" ::: "memory");
    float rli[16];
#pragma unroll
    for (int r = 0; r < 16; ++r) rli[r] = __builtin_amdgcn_rcpf(li_l[crow(r, hi)]);
    bf16* Ow = cur.O + (size_t)(wid * QBLK) * PITCH; const unsigned ooff = 4 * hi * PITCH + r32;
#pragma unroll
    for (int r = 0; r < 16; ++r) { const int orow = crow(r, hi);
#pragma unroll
        for (int d0 = 0; d0 < 4; ++d0) { const float v = o[d0][r] * rli[r];
            const float vn = __shfl_xor(v, 1);
            if ((r32 & 1) == 0) *(unsigned*)(Ow + ((r & 3) + 8 * (r >> 2)) * PITCH + d0 * 32 + ooff) = cvtpk(v, vn); } }
    __syncthreads();
#undef RESC
#undef KBASE
#undef MASKT
#undef SEAM_K0
#undef HALF_STEP
}
#undef ROW
#undef VMW
#undef VMWN
#undef SLOAD_H
#undef SWRITE_HK
#undef SWRITE_HV
#undef SWRITE_H
}
namespace swa {
typedef unsigned short bf16;
typedef short bf16x8 __attribute__((ext_vector_type(8)));
typedef short s16x4 __attribute__((ext_vector_type(4)));
typedef float f32x16 __attribute__((ext_vector_type(16)));
typedef float f32x4 __attribute__((ext_vector_type(4)));
typedef unsigned u32x4 __attribute__((ext_vector_type(4)));
#define SLAS __attribute__((address_space(3)))
using fox::cvtpk;
constexpr int QKVP = 2560, OP = 2048, KROW = 144;
constexpr int LDS_K = 0, LDS_V = 256 * KROW, LDS_WS = LDS_V + 256 * 64 * 2, LDS_BYTES = LDS_WS + 8 * 256;
__device__ __forceinline__ int v_st2(int k, int c) { const int kk = (k & ~0xC) | ((k & 4) << 1) | ((k & 8) >> 1); return ((kk >> 3) * 2 + (c >> 5)) * 512 + ((kk & 7) * 32 + (c & 31)) * 2; }
__device__ __forceinline__ float bf_lo(unsigned w) { return __uint_as_float(w << 16); }
__device__ __forceinline__ float bf_hi(unsigned w) { return __uint_as_float(w & 0xffff0000u); }
__device__ __forceinline__ u32x4 rope8(u32x4 own, u32x4 oth, const float* tab, bool second) {
    const f32x4 c0 = *(const f32x4*)(tab), c1 = *(const f32x4*)(tab + 4), s0 = *(const f32x4*)(tab + 8), s1 = *(const f32x4*)(tab + 12);
    const float sg = second ? 1.f : -1.f;
    float cs[8] = {c0[0], c0[1], c0[2], c0[3], c1[0], c1[1], c1[2], c1[3]}, sn[8] = {s0[0], s0[1], s0[2], s0[3], s1[0], s1[1], s1[2], s1[3]};
    u32x4 r;
#pragma unroll
    for (int i = 0; i < 4; ++i) { const float a0 = bf_lo(own[i]), a1 = bf_hi(own[i]), b0 = bf_lo(oth[i]), b1 = bf_hi(oth[i]);
        const float o0 = a0 * cs[2 * i] + sg * b0 * sn[2 * i], o1 = a1 * cs[2 * i + 1] + sg * b1 * sn[2 * i + 1];
        r[i] = fox::cvtpk(o0, o1); }
    return r;
}
__device__ __forceinline__ void unit(int b, int n, int hk, const bf16* QKV, bf16* O, const float* rope, const float* sinks, char* lds) {
    const int tid = opaque_tid(), wid = __builtin_amdgcn_readfirstlane(tid >> 6), lane = tid & 63, r32 = lane & 31, hi = lane >> 5;
    const bf16* base = QKV + (size_t)(b * 2048) * QKVP;
    SLAS char* l3 = (SLAS char*)lds;
#pragma unroll
    for (int i = 0; i < 4; ++i) { const int row = i * 64 + (tid >> 3), c = tid & 7, s = 128 * (n - 1) + row; const bool valid = s >= 0;
        u32x4 kv = {0u, 0u, 0u, 0u}, vv = {0u, 0u, 0u, 0u};
        if (valid) { kv = *(const u32x4*)(base + (size_t)s * QKVP + 2048 + hk * 64 + 8 * c); vv = *(const u32x4*)(base + (size_t)s * QKVP + 2304 + hk * 64 + 8 * c); }
        u32x4 ot; ot[0] = __shfl_xor(kv[0], 1); ot[1] = __shfl_xor(kv[1], 1); ot[2] = __shfl_xor(kv[2], 1); ot[3] = __shfl_xor(kv[3], 1);
        if (c < 2 && valid) kv = rope8(kv, ot, rope + (size_t)(b * 2048 + s) * 16, c == 1);
        *(SLAS u32x4*)(l3 + LDS_K + row * KROW + c * 16) = kv;
        *(SLAS u32x4*)(l3 + LDS_V + v_st2(row, 8 * c)) = vv; }
    __syncthreads();
    const int hq = hk * 8 + wid;
    const float sinkL = sinks[hq] * 1.4426950408889634f;
    constexpr float C2 = 0.125f * 1.4426950408889634f;
    const int vb0 = LDS_V + fox::v_rd_base(lane);
    SLAS float* li_l = (SLAS float*)(l3 + LDS_WS + wid * 256);
    for (int c4 = 0; c4 < 4; ++c4) {
        const int qrow = b * 2048 + 128 * n + 32 * c4 + r32;
        bf16x8 qr[4];
#pragma unroll
        for (int ks = 0; ks < 4; ++ks) qr[ks] = *(const bf16x8*)(base + (size_t)(128 * n + 32 * c4 + r32) * QKVP + hq * 64 + 16 * ks + 8 * hi);
        { u32x4 own = __builtin_bit_cast(u32x4, qr[0]); u32x4 ot; ot[0] = __shfl_xor(own[0], 32); ot[1] = __shfl_xor(own[1], 32); ot[2] = __shfl_xor(own[2], 32); ot[3] = __shfl_xor(own[3], 32);
          own = rope8(own, ot, rope + (size_t)qrow * 16, hi == 1); qr[0] = __builtin_bit_cast(bf16x8, own); }
        f32x16 p[5];
#pragma unroll
        for (int jb = 0; jb < 5; ++jb) { p[jb] = f32x16{};
            const SLAS char* kp = l3 + LDS_K + (32 * c4 + 32 * jb + r32) * KROW + hi * 16;
#pragma unroll
            for (int ks = 0; ks < 4; ++ks) { const bf16x8 a = *(const SLAS bf16x8*)(kp + ks * 32); p[jb] = __builtin_amdgcn_mfma_f32_32x32x16_bf16(a, qr[ks], p[jb], 0, 0, 0); } }
        float mx = sinkL;
#pragma unroll
        for (int jb = 0; jb < 5; ++jb) { const bool dead = (n == 0) && (c4 + jb < 4);
#pragma unroll
            for (int r = 0; r < 16; ++r) { const int rel = r32 + 128 - 32 * jb - fox::crow(r, hi); const bool ok = ((unsigned)rel < 128u) && !dead;
                const float t = ok ? p[jb][r] * C2 : -__builtin_inff(); p[jb][r] = t; mx = fmaxf(mx, t); } }
        { auto rr = __builtin_amdgcn_permlane32_swap(__float_as_uint(mx), __float_as_uint(mx), false, false); mx = fmaxf(__uint_as_float(rr[0]), __uint_as_float(rr[1])); }
        float ps = 0.f;
#pragma unroll
        for (int jb = 0; jb < 5; ++jb)
#pragma unroll
            for (int r = 0; r < 16; ++r) { const float e = __builtin_amdgcn_exp2f(p[jb][r] - mx); p[jb][r] = e; ps += e; }
        { auto rr = __builtin_amdgcn_permlane32_swap(__float_as_uint(ps), __float_as_uint(ps), false, false); ps = __uint_as_float(rr[0]) + __uint_as_float(rr[1]); }
        ps += __builtin_amdgcn_exp2f(sinkL - mx);
        f32x16 o[2]; o[0] = f32x16{}; o[1] = f32x16{};
#pragma unroll
        for (int jb = 0; jb < 5; ++jb) { bf16x8 pa0, pa1; PK4(p[jb], 0, pa0); PK4(p[jb], 8, pa1);
            const SLAS char* vp = l3 + vb0 + (2 * c4 + 2 * jb) * 2048;
#pragma unroll
            for (int d0 = 0; d0 < 2; ++d0) {
                const s16x4 l0 = __builtin_bit_cast(s16x4, __builtin_amdgcn_ds_read_tr16_b64_v4i16((SLAS s16x4*)(vp + d0 * 512)));
                const s16x4 h0 = __builtin_bit_cast(s16x4, __builtin_amdgcn_ds_read_tr16_b64_v4i16((SLAS s16x4*)(vp + d0 * 512 + 1024)));
                const s16x4 l1 = __builtin_bit_cast(s16x4, __builtin_amdgcn_ds_read_tr16_b64_v4i16((SLAS s16x4*)(vp + d0 * 512 + 2048)));
                const s16x4 h1 = __builtin_bit_cast(s16x4, __builtin_amdgcn_ds_read_tr16_b64_v4i16((SLAS s16x4*)(vp + d0 * 512 + 3072)));
                o[d0] = __builtin_amdgcn_mfma_f32_32x32x16_bf16(pa0, (bf16x8){l0[0], l0[1], l0[2], l0[3], h0[0], h0[1], h0[2], h0[3]}, o[d0], 0, 0, 0);
                o[d0] = __builtin_amdgcn_mfma_f32_32x32x16_bf16(pa1, (bf16x8){l1[0], l1[1], l1[2], l1[3], h1[0], h1[1], h1[2], h1[3]}, o[d0], 0, 0, 0); } }
        if (hi == 0) li_l[r32] = ps;
        asm volatile("s_waitcnt lgkmcnt(0)" ::: "memory");
        bf16* Ow = O + (size_t)(b * 2048 + 128 * n + 32 * c4) * OP + hq * 64;
#pragma unroll
        for (int r = 0; r < 16; ++r) { const int orow = fox::crow(r, hi); const float rl = __builtin_amdgcn_rcpf(li_l[orow]);
#pragma unroll
            for (int d0 = 0; d0 < 2; ++d0) { const float v = o[d0][r] * rl; const float vn = __shfl_xor(v, 1);
                if ((r32 & 1) == 0) *(unsigned*)(Ow + (size_t)orow * OP + d0 * 32 + r32) = fox::cvtpk(v, vn); } }
        asm volatile("s_waitcnt lgkmcnt(0)" ::: "memory");
    }
    __syncthreads();
}
}
#define LAS __attribute__((address_space(3)))
typedef unsigned short bf16_t;
typedef float f32x4 __attribute__((ext_vector_type(4)));
typedef unsigned u32x4 __attribute__((ext_vector_type(4)));
typedef unsigned u32x2 __attribute__((ext_vector_type(2)));
typedef short bf16x8 __attribute__((ext_vector_type(8)));
constexpr int M = 16384, DM = 2048, SEQ = 2048, NB = 8, DFF = 5632, NFIN = 6160, NSIN = 2560;
constexpr float LN_EPS = 1e-5f, ALPHA = 1.4142135623730951f;
constexpr size_t MiB = 1u << 20;
constexpr size_t WS_MOD = 1 * MiB;
constexpr size_t WS_STATS = 1 * MiB + 786432;
constexpr size_t WS_ROPE = 2 * MiB;
constexpr size_t WS_LOGF = 3 * MiB;
constexpr size_t WS_UBUF = 4 * MiB;
constexpr size_t WS_WFIN = 16 * MiB;
constexpr size_t WS_WFO = 42 * MiB;
constexpr size_t WS_WSIN = 50 * MiB;
constexpr size_t WS_WSO = 60 * MiB;
constexpr size_t WS_WUP = 68 * MiB;
constexpr size_t WS_WDN = 156 * MiB;
constexpr size_t WS_H = 200 * MiB;
constexpr size_t WS_Z = 264 * MiB;
constexpr size_t WS_Q = 392 * MiB;
constexpr size_t WS_K = 456 * MiB, WS_V = 520 * MiB;
constexpr size_t WS_O = 584 * MiB;
constexpr size_t WS_END = 648 * MiB;
static_assert(WSO_MOD == WS_MOD && WSO_STATS == WS_STATS && WSO_Z == WS_Z && WSO_UBUF == WS_UBUF && WSO_Q == WS_Q, "ws map");
constexpr int LDS_HALO = 131072, LDS_PTAB = 139264, LDS_XB = 139264 + 512, LDS_BYTES = 147456;

__device__ __forceinline__ unsigned pk2(float lo, float hi) { return pg8::cvt_pk_bf16(lo, hi); }
__device__ __forceinline__ float wave_sum(float v) {
#pragma unroll
    for (int o = 1; o < 64; o <<= 1) v += __shfl_xor(v, o);
    return v;
}
__device__ __forceinline__ int perm_up(int n) { const int half = n >= DFF ? 1 : 0, ch = n - half * DFF; return (ch >> 7) * 256 + half * 128 + (ch & 127); }
template <int MODE> __device__ __forceinline__ void tr_item(const float* W, int K, int N, bf16_t* WT, LAS float* scr, int item, int lane) {
    const int nblk = (N + 31) / 32, kb = item / nblk, nb = item % nblk, k0 = 64 * kb, n0 = 32 * nb;
    const int nn = n0 + (lane & 31); const bool ok = nn < N;
#pragma unroll 8
    for (int i = 0; i < 32; ++i) { const int kk = 2 * i + (lane >> 5); scr[kk * 33 + (lane & 31)] = ok ? W[(size_t)(k0 + kk) * N + nn] : 0.f; }
    asm volatile("s_waitcnt lgkmcnt(0)" ::: "memory");
    const int c = lane & 7;
#pragma unroll
    for (int j = 0; j < 4; ++j) { const int n = (lane >> 3) + 8 * j; const LAS float* s = scr + (8 * c) * 33 + n;
        u32x4 o; o.x = pk2(s[0 * 33], s[1 * 33]); o.y = pk2(s[2 * 33], s[3 * 33]); o.z = pk2(s[4 * 33], s[5 * 33]); o.w = pk2(s[6 * 33], s[7 * 33]);
        const int ng = n0 + n; if (ng < N) { const int dr = MODE == 1 ? perm_up(ng) : ng; *(u32x4*)(WT + (size_t)dr * K + k0 + 8 * c) = o; } }
    asm volatile("s_waitcnt lgkmcnt(0)" ::: "memory");
}
template <int MODE> __device__ __forceinline__ void tr64_item(const float* W, int K, int N, bf16_t* WT, LAS float* scr, int item, int lane) {
    const int nblk = (N + 63) / 64, kb = item / nblk, nb = item % nblk, k0 = 64 * kb, n0 = 64 * nb;
    const int kr = lane >> 4, c4 = (lane & 15) * 4, nn = n0 + c4; const bool ok = nn < N;
    f32x4 v[16];
    const float* wp = W + (size_t)(k0 + kr) * N + nn;
#pragma unroll
    for (int i = 0; i < 16; ++i) v[i] = ok ? *(const f32x4*)(wp + (size_t)(4 * i) * N) : (f32x4){0.f, 0.f, 0.f, 0.f};
#pragma unroll
    for (int i = 0; i < 16; ++i) { LAS float* d = scr + (4 * i + kr) * 65 + c4; d[0] = v[i][0]; d[1] = v[i][1]; d[2] = v[i][2]; d[3] = v[i][3]; }
    asm volatile("s_waitcnt lgkmcnt(0)" ::: "memory");
    const int c = lane & 7;
#pragma unroll
    for (int j = 0; j < 8; ++j) { const int n = (lane >> 3) + 8 * j; const LAS float* s = scr + (8 * c) * 65 + n;
        u32x4 o; o.x = pk2(s[0 * 65], s[1 * 65]); o.y = pk2(s[2 * 65], s[3 * 65]); o.z = pk2(s[4 * 65], s[5 * 65]); o.w = pk2(s[6 * 65], s[7 * 65]);
        const int ng = n0 + n; if (ng < N) { const int dr = MODE == 1 ? perm_up(ng) : ng; *(u32x4*)(WT + (size_t)dr * K + k0 + 8 * c) = o; } }
    asm volatile("s_waitcnt lgkmcnt(0)" ::: "memory");
}
__device__ __forceinline__ float log_sigmoid(float x) { return fminf(x, 0.f) - log1pf(expf(-fabsf(x))); }

#define XB_TMO      128
#define XB_XCNT(j)  (256  + 64 * (j))
#define XB_XSUB(j)  (1280 + 64 * (j))
#define XB_XGEN(j)  (2304 + 64 * (j))
#define XB_TOP      3328
#define XB_TOPGEN   3392
#define XCD_BAR_WORDS 3456
#define XB_SPIN_CAP (1u << 18)

__device__ __forceinline__ unsigned xb_ld(unsigned* p)              { return __hip_atomic_load(p, __ATOMIC_RELAXED, __HIP_MEMORY_SCOPE_AGENT); }
__device__ __forceinline__ unsigned xb_add(unsigned* p, unsigned v) { return __hip_atomic_fetch_add(p, v, __ATOMIC_RELAXED, __HIP_MEMORY_SCOPE_AGENT); }
__device__ __forceinline__ unsigned xb_xcc_id() { return (unsigned)__builtin_amdgcn_s_getreg((3 << 11) | 20) & 0xFu; }
#define XB_SPIN(cond, bar) do { unsigned _sp = 0; while (cond) { __builtin_amdgcn_s_sleep(1); \
    if ((++_sp & 255u) == 0u) { if (xb_ld(&(bar)[XB_TMO])) break; if (_sp > XB_SPIN_CAP) { atomicAdd(&(bar)[XB_TMO], 1u); break; } } } } while (0)

struct XcdBarrier {
    unsigned* bar; unsigned x;
    volatile LAS unsigned* st;
};

__device__ __forceinline__ XcdBarrier xcd_barrier_post(unsigned* bar, volatile LAS unsigned* st) {
    XcdBarrier b; b.bar = bar; b.x = xb_xcc_id(); b.st = st;
    if (threadIdx.x == 0) (void)xb_add(&bar[XB_XCNT(b.x)], 1u);
    return b;
}
__device__ __forceinline__ void xcd_barrier_complete(unsigned* bar, unsigned x, unsigned& nloc, unsigned& nx) {
    const unsigned G = gridDim.x * gridDim.y * gridDim.z;
    unsigned sum, cnt, mine, sp = 0u;
    for (;;) {
        sum = 0u; cnt = 0u; mine = 0u;
#pragma unroll
        for (unsigned j = 0; j < 16; ++j) { const unsigned c = xb_ld(&bar[XB_XCNT(j)]); sum += c; cnt += (c > 0u) ? 1u : 0u; mine = (j == x) ? c : mine; }
        if (sum == G) break;
        __builtin_amdgcn_s_sleep(1);
        if ((++sp & 255u) == 0u) { if (xb_ld(&bar[XB_TMO])) break; if (sp > XB_SPIN_CAP) { atomicAdd(&bar[XB_TMO], 1u); break; } }
    }
    nloc = mine > 0u ? mine : 1u; nx = cnt > 0u ? cnt : 1u;
}

__device__ __forceinline__ void xcd_barrier(const XcdBarrier& b) {
    asm volatile("s_waitcnt vmcnt(0)" ::: "memory");
    __syncthreads();
    if (threadIdx.x == 0) {
        unsigned* bar = b.bar;
        __builtin_amdgcn_s_waitcnt(0);
        unsigned nloc = b.st[0], nx = b.st[1];
        if (nloc == 0u) { xcd_barrier_complete(bar, b.x, nloc, nx); b.st[0] = nloc; b.st[1] = nx; }
        const unsigned old = xb_add(&bar[XB_XSUB(b.x)], 1u);
        const unsigned gen = old / nloc;
        if (old + 1u == (gen + 1u) * nloc) {
            __builtin_amdgcn_fence(__ATOMIC_RELEASE, "agent");
            asm volatile("s_waitcnt vmcnt(0)" ::: "memory");
            const unsigned og = xb_add(&bar[XB_TOP], 1u);
            const unsigned tg = og / nx;
            if (og + 1u == (tg + 1u) * nx) xb_add(&bar[XB_TOPGEN], 1u);
            else XB_SPIN(xb_ld(&bar[XB_TOPGEN]) == tg, bar);
            __builtin_amdgcn_fence(__ATOMIC_ACQUIRE, "agent");
            xb_add(&bar[XB_XGEN(b.x)], 1u);
            asm volatile("s_waitcnt vmcnt(0)" ::: "memory");
        } else {
            XB_SPIN(xb_ld(&bar[XB_XGEN(b.x)]) == gen, bar);
            __builtin_amdgcn_fence(__ATOMIC_ACQUIRE, "agent");
            asm volatile("s_waitcnt vmcnt(0)" ::: "memory");
        }
    }
    __syncthreads();
}

#ifndef DUPMASK
#define DUPMASK 0
#endif
#define DUP(k) for (int rep_ = 0; rep_ < 1 + ((DUPMASK >> (k)) & 1); ++rep_)
#ifndef PH
#define PH 0xFFFF
#endif
#define ON(k) ((PH >> (k)) & 1)
struct Args { const void* in[19]; float* out; unsigned char* ws; };


__global__ void __launch_bounds__(512, 2) fwd_kernel(Args a) {
    extern __shared__ __attribute__((aligned(16))) unsigned char lds[];
    cg::grid_group grid = cg::this_grid();
#define tid (opaque_tid())
#define lane (opaque_tid() & 63)
#define wid (__builtin_amdgcn_readfirstlane(opaque_tid() >> 6))
    constexpr int G = 256, NGW = G * 8;
#define bid ((int)blockIdx.x)
#define vcu ((bid % 8) * (G / 8) + bid / 8)
#define gw (bid * 8 + wid)
    ptab_t ptab = (ptab_t)(lds + LDS_PTAB);
    if (tid < 19) ptab[tid] = (unsigned long long)a.in[tid];
    if (tid == 19) ptab[19] = (unsigned long long)a.out;
    if (tid == 20) ptab[20] = (unsigned long long)a.ws;
    if (tid == 21) { ((LAS unsigned*)(lds + LDS_XB))[0] = 0u; ((LAS unsigned*)(lds + LDS_XB))[1] = 0u; }
    __syncthreads();
    (void)xcd_barrier_post((unsigned*)a.ws, (volatile LAS unsigned*)(lds + LDS_XB));
    if (a.out == nullptr) grid.sync();
#define GBAR() do { XcdBarrier b_; b_.bar = (unsigned*)WSP; b_.x = xb_xcc_id(); b_.st = (volatile LAS unsigned*)(lds + LDS_XB); xcd_barrier(b_); } while (0)
#define LDP(i) ldp(ptab, (i))
#define x_in ((const float*)LDP(0))
#define c_in ((const float*)LDP(1))
#define pos_in ((const int*)LDP(2))
#define fox_w_in ((const float*)LDP(3))
#define fox_b_f ((const float*)LDP(4))
#define fox_w_o ((const float*)LDP(5))
#define swa_w_in ((const float*)LDP(6))
#define swa_sinks ((const float*)LDP(7))
#define swa_w_o ((const float*)LDP(8))
#define ada_w ((const float*)LDP(9))
#define ada_b ((const float*)LDP(10))
#define ffn_w_up ((const float*)LDP(11))
#define ffn_conv_w ((const float*)LDP(12))
#define ffn_conv_b ((const float*)LDP(13))
#define ffn_w_down ((const float*)LDP(14))
#define ln_mix_g ((const float*)LDP(15))
#define ln_mix_b ((const float*)LDP(16))
#define ln_ffn_g ((const float*)LDP(17))
#define ln_ffn_b ((const float*)LDP(18))
#define xcur ((float*)LDP(19))
#define WSP ((unsigned char*)LDP(20))
#define mod ((float*)(WSP + WS_MOD))
#define rope ((float*)(WSP + WS_ROPE))
#define stats_ ((float*)(WSP + WS_STATS))
#define logf_ ((float*)(WSP + WS_LOGF))
#define ubuf ((float*)(WSP + WS_UBUF))
#define Wfin ((bf16_t*)(WSP + WS_WFIN))
#define Wfo ((bf16_t*)(WSP + WS_WFO))
#define Wsin ((bf16_t*)(WSP + WS_WSIN))
#define Wso ((bf16_t*)(WSP + WS_WSO))
#define Wup ((bf16_t*)(WSP + WS_WUP))
#define Wdn ((bf16_t*)(WSP + WS_WDN))
#define Hb ((bf16_t*)(WSP + WS_H))
#define Zb ((float*)(WSP + WS_Z))
#define Qb ((bf16_t*)(WSP + WS_Q))
#define Kb ((bf16_t*)(WSP + WS_K))
#define Vb ((bf16_t*)(WSP + WS_V))
#define Ob ((bf16_t*)(WSP + WS_O))
#define Actb Qb

    DUP(0) {
    __syncthreads();
    if (ON(0)) {
        const int i = bid * 512 + tid;
        float* rope_ = rope; const int* pos_ = pos_in;
        if (i < M * 8) { const int m = i >> 3, f = i & 7;
            const float inv = f == 0 ? 1.0f : f == 1 ? 0.1939227432012558f : f == 2 ? 0.03760603070259094f : f == 3 ? 0.007292664609849453f : f == 4 ? 0.0014142135623842478f : f == 5 ? 0.00027424818836152554f : f == 6 ? 5.3182957344688475e-05f : 1.0313385246263351e-05f;
            const float ang = (float)pos_[m] * inv; float sn, cs; sincosf(ang, &sn, &cs);
            rope_[m * 16 + f] = cs; rope_[m * 16 + 8 + f] = sn; }
    }
    if (ON(1) && bid < 192) {
        LAS float* sc = (LAS float*)lds; LAS float* red = (LAS float*)(lds + 65536);
        const float* cin_ = c_in; const float* adaw_ = ada_w; const float* adab_ = ada_b; float* mod_ = mod;
        for (int i = tid; i < NB * DM; i += 512) { const int b = i >> 11, k = i & 2047; const float v = cin_[i]; sc[k * 8 + b] = v / (1.f + expf(-v)); }
        __syncthreads();
        const int l = bid / 96, n0 = (bid % 96) * 128, kq = tid >> 5, cl = tid & 31;
        const float* W = adaw_ + (size_t)l * DM * 12288 + n0 + 4 * cl;
        f32x4 acc[8];
#pragma unroll
        for (int b = 0; b < 8; ++b) acc[b] = (f32x4){0.f, 0.f, 0.f, 0.f};
#pragma unroll 8
        for (int kk = 0; kk < 128; ++kk) { const int k = kq + 16 * kk; const f32x4 w = *(const f32x4*)(W + (size_t)k * 12288);
            const f32x4 s0 = *(const LAS f32x4*)(sc + k * 8), s1 = *(const LAS f32x4*)(sc + k * 8 + 4);
            acc[0] += w * s0[0]; acc[1] += w * s0[1]; acc[2] += w * s0[2]; acc[3] += w * s0[3]; acc[4] += w * s1[0]; acc[5] += w * s1[1]; acc[6] += w * s1[2]; acc[7] += w * s1[3]; }
#pragma unroll
        for (int b = 0; b < 8; ++b) *(LAS f32x4*)(red + (kq * 8 + b) * 128 + 4 * cl) = acc[b];
        __syncthreads();
        for (int o = tid; o < 1024; o += 512) { const int b = o >> 7, col = o & 127; float s = 0.f;
#pragma unroll
            for (int q = 0; q < 16; ++q) s += red[(q * 8 + b) * 128 + col];
            mod_[(size_t)(l * 8 + b) * 12288 + n0 + col] = s + adab_[l * 12288 + n0 + col]; }
        __syncthreads();
    }
    if (ON(2)) {
        LAS float* scr = (LAS float*)(lds + wid * 16640);
        const float* p_fin = fox_w_in; const float* p_fo = fox_w_o; const float* p_sin = swa_w_in; const float* p_so = swa_w_o; const float* p_up = ffn_w_up; const float* p_dn = ffn_w_down; unsigned char* wsl = WSP;
        constexpr int I_FIN = 32 * 97, I_SQ = 32 * 32, I_SIN = 32 * 40, I_UP = 32 * 176, I_DN = 88 * 32;
        constexpr int NITEMS = I_FIN + 2 * I_SQ + I_SIN + 2 * I_UP + 2 * I_DN;
        unsigned* qctr = (unsigned*)(wsl + 15360);
        const int ln_ = lane;
        constexpr int NS_ADA = 9, NS_FREE = 14, NSTATIC = 192 * 8 * NS_ADA + 64 * 8 * NS_FREE;
        static_assert(NSTATIC <= NITEMS, "static share");
        const int gw_ = gw; const int nst = (bid < 192) ? NS_ADA : NS_FREE; const int sbase = (bid < 192) ? gw_ * NS_ADA : 192 * 8 * NS_ADA + (gw_ - 192 * 8) * NS_FREE;
        for (int si = 0;; ++si) {
            int r;
            if (si < nst) r = sbase + si;
            else { unsigned itv = 0u; if (ln_ == 0) itv = __hip_atomic_fetch_add(qctr, 1u, __ATOMIC_RELAXED, __HIP_MEMORY_SCOPE_AGENT);
                   r = NSTATIC + (int)__builtin_amdgcn_readfirstlane(itv); if (r >= NITEMS) break; }
            if (r < 2 * I_UP) { const int l = r / I_UP; tr64_item<1>(p_up + (size_t)l * DM * 2 * DFF, DM, 2 * DFF, (bf16_t*)(wsl + WS_WUP) + (size_t)l * 2 * DFF * DM, scr, r - l * I_UP, ln_); continue; } r -= 2 * I_UP;
            if (r < 2 * I_DN) { const int l = r / I_DN; tr64_item<0>(p_dn + (size_t)l * DFF * DM, DFF, DM, (bf16_t*)(wsl + WS_WDN) + (size_t)l * DM * DFF, scr, r - l * I_DN, ln_); continue; } r -= 2 * I_DN;
            if (r < I_FIN) { tr64_item<0>(p_fin, DM, NFIN, (bf16_t*)(wsl + WS_WFIN), scr, r, ln_); continue; } r -= I_FIN;
            if (r < I_SQ) { tr64_item<0>(p_fo, DM, DM, (bf16_t*)(wsl + WS_WFO), scr, r, ln_); continue; } r -= I_SQ;
            if (r < I_SIN) { tr64_item<0>(p_sin, DM, NSIN, (bf16_t*)(wsl + WS_WSIN), scr, r, ln_); continue; } r -= I_SIN;
            tr64_item<0>(p_so, DM, DM, (bf16_t*)(wsl + WS_WSO), scr, r, ln_);
        }
    }
    }
    GBAR();

    for (int l = 0; l < 2; ++l) {
#define modl (mod + (size_t)l * 8 * 12288)
        if (ON(3) && l == 0) {
            const float* xin_ = x_in; const float* mod0_ = modl; bf16_t* hb_ = Hb; const int ln_ = lane;
            for (int m = gw * 2; m < M; m += NGW * 2) { const float* sh = mod0_ + (size_t)(m >> 11) * 12288; const float* scv = sh + 2048;
                const f32x4* xr = (const f32x4*)(xin_ + (size_t)m * DM) + ln_; u32x2* ho = (u32x2*)(hb_ + (size_t)m * DM) + ln_; f32x4 v[2][8];
#pragma unroll
                for (int q = 0; q < 2; ++q)
#pragma unroll
                    for (int j = 0; j < 8; ++j) v[q][j] = xr[q * (DM / 4) + 64 * j];
#pragma unroll
                for (int j = 0; j < 8; ++j) { const f32x4 sv = *((const f32x4*)scv + ln_ + 64 * j) + 1.0f, tv = *((const f32x4*)sh + ln_ + 64 * j);
#pragma unroll
                    for (int q = 0; q < 2; ++q) { const f32x4 h = v[q][j] * sv + tv; u32x2 w; w.x = pk2(h[0], h[1]); w.y = pk2(h[2], h[3]); ho[q * (DM / 4) + 64 * j] = w; } } }
            GBAR();
        }
        if (l == 0) {
            if (ON(4) && wid < 4) { const int m0 = (bid * 4 + wid) * 16; const bf16_t* hb_ = Hb; const bf16_t* wf_ = Wfin; const float* bfp_ = fox_b_f; float* lfo_ = logf_;
                if (m0 < M) { const bf16_t* ap = hb_ + (size_t)(m0 + (lane & 15)) * DM + 8 * (lane >> 4); const bf16_t* bp = wf_ + (size_t)(6144 + (lane & 15)) * DM + 8 * (lane >> 4);
                    f32x4 c0 = {0.f, 0.f, 0.f, 0.f}, c1 = c0, c2 = c0, c3 = c0;
#pragma unroll 2
                    for (int kk = 0; kk < 64; kk += 4) {
                        c0 = __builtin_amdgcn_mfma_f32_16x16x32_bf16(*(const bf16x8*)(ap + kk * 32), *(const bf16x8*)(bp + kk * 32), c0, 0, 0, 0);
                        c1 = __builtin_amdgcn_mfma_f32_16x16x32_bf16(*(const bf16x8*)(ap + kk * 32 + 32), *(const bf16x8*)(bp + kk * 32 + 32), c1, 0, 0, 0);
                        c2 = __builtin_amdgcn_mfma_f32_16x16x32_bf16(*(const bf16x8*)(ap + kk * 32 + 64), *(const bf16x8*)(bp + kk * 32 + 64), c2, 0, 0, 0);
                        c3 = __builtin_amdgcn_mfma_f32_16x16x32_bf16(*(const bf16x8*)(ap + kk * 32 + 96), *(const bf16x8*)(bp + kk * 32 + 96), c3, 0, 0, 0); }
                    const f32x4 cs = (c0 + c1) + (c2 + c3); const float bf = bfp_[lane & 15];
#pragma unroll
                    for (int r = 0; r < 4; ++r) lfo_[(size_t)(m0 + (lane >> 4) * 4 + r) * 16 + (lane & 15)] = log_sigmoid(cs[r] + bf); } }
            DUP(8) if (ON(5)) { pg8::Gemm g{Hb, Wfin, M, 6144, DM}; pg8::StaticOrder S; S.init(M, 6144, G, bid);
              pg8::EpiBf16 E{ptab, DM, DM, (size_t)(WS_K - WS_Q) / 2};
              pg8::gemm_phase<pg8::EpiBf16, pg8::StaticOrder, true, true>((LAS unsigned char*)lds, g, S, E); }
            GBAR();
            DUP(2) if (ON(6)) {
                fox::Seam S;
                auto mk = [](int j, int vcu_, const bf16_t* Q, const bf16_t* K, const bf16_t* V, bf16_t* O, const float* lf) {
                    const int item = vcu_ + 256 * (j >> 1), bh = item >> 2, xq = item & 3, qb = (j & 1) ? 7 - xq : xq, b = bh >> 4, h = bh & 15;
                    fox::BlockRef r; const size_t ro = (size_t)(b * SEQ) * DM + h * 128;
                    r.Q = Q + ro + (size_t)(qb * 256) * DM; r.K = K + ro; r.V = V + ro; r.O = O + ro + (size_t)(qb * 256) * DM; r.lf = lf + (size_t)(b * SEQ) * 16 + h; r.P0 = qb * 256; return r; };
                { const float* lfp_ = logf_;
                  for (int j = 0; j < 4; ++j) { const fox::BlockRef r = mk(j, vcu, nullptr, nullptr, nullptr, nullptr, lfp_); fox::key_bias(r, (char*)lds, j); } }
                int vc2 = vcu; asm volatile("" : "+s"(vc2));
                const bf16_t* q_ = Qb; const bf16_t* k_ = Kb; const bf16_t* v_ = Vb; bf16_t* o_ = Ob;
                fox::BlockRef cur = mk(0, vc2, q_, k_, v_, o_, nullptr);
                fox::prime(cur, (char*)lds, S);
                for (int j = 0; j < 4; ++j) { const fox::BlockRef nxt = (j < 3) ? mk(j + 1, vc2, q_, k_, v_, o_, nullptr) : cur;
                    fox::block(cur, nxt, (char*)lds, S, j); cur = nxt; }
            }
            GBAR();
        } else {
            if (ON(7)) { pg8::Gemm g{Hb, Wsin, M, NSIN, DM}; pg8::StaticOrder S; S.init(M, NSIN, G, bid);
              pg8::EpiBf16 E{ptab, NSIN, 0, 0};
              pg8::gemm_phase<pg8::EpiBf16, pg8::StaticOrder, true, true>((LAS unsigned char*)lds, g, S, E); }
            GBAR();
            DUP(4) if (ON(8)) { const bf16_t* qkv_ = Qb; bf16_t* o_ = Ob; const float* rp_ = rope; const float* sk_ = swa_sinks;
              for (int u = vcu; u < 512; u += G) { const int hk = u & 3, n = (u >> 2) & 15, b = u >> 6; swa::unit(b, n, hk, qkv_, o_, rp_, sk_, (char*)lds); } }
            GBAR();
        }
        DUP(6) if (ON(9)) { pg8::Gemm g{Ob, l == 0 ? Wfo : Wso, M, DM, DM}; pg8::StaticOrder S; S.init(M, DM, G, bid);
          pg8::EpiZ E{ptab, l, 0};
          pg8::gemm_phase<pg8::EpiZ, pg8::StaticOrder, true, true>((LAS unsigned char*)lds, g, S, E); }
        GBAR();
#define LN_PHASE(GV, BV, SHV, SCV, WRITE_H, WRITE_X) do { const float* zb_ = Zb; float* xc_ = xcur; bf16_t* hb_ = Hb; float* st_ = stats_; const float* gv_ = (GV); const float* bv_ = (BV); const float* shv_ = (SHV); const float* scv_ = (SCV); \
        const int ln_ = lane; \
        for (int m = gw * 2; m < M; m += NGW * 2) { const f32x4* zr = (const f32x4*)(zb_ + (size_t)m * DM) + ln_; f32x4 v[2][8]; float s[2] = {0.f, 0.f}; \
            _Pragma("unroll") for (int q = 0; q < 2; ++q) _Pragma("unroll") for (int j = 0; j < 8; ++j) v[q][j] = zr[q * (DM / 4) + 64 * j]; \
            _Pragma("unroll") for (int q = 0; q < 2; ++q) _Pragma("unroll") for (int j = 0; j < 8; ++j) s[q] += (v[q][j][0] + v[q][j][1]) + (v[q][j][2] + v[q][j][3]); \
            float mean[2], rstd[2]; \
            _Pragma("unroll") for (int q = 0; q < 2; ++q) { mean[q] = wave_sum(s[q]) * (1.f / DM); float s2 = 0.f; \
                _Pragma("unroll") for (int j = 0; j < 8; ++j) { v[q][j] = v[q][j] - mean[q]; s2 += (v[q][j][0] * v[q][j][0] + v[q][j][1] * v[q][j][1]) + (v[q][j][2] * v[q][j][2] + v[q][j][3] * v[q][j][3]); } \
                rstd[q] = 1.f / sqrtf(wave_sum(s2) * (1.f / DM) + LN_EPS); } \
            if (ln_ < 2) { st_[2 * (m + ln_)] = ln_ ? mean[1] : mean[0]; st_[2 * (m + ln_) + 1] = ln_ ? rstd[1] : rstd[0]; } \
            const float* shp = shv_ + (size_t)(m >> 11) * 12288; const float* scp = scv_ + (size_t)(m >> 11) * 12288; \
            _Pragma("unroll") for (int j = 0; j < 8; ++j) { const f32x4 gg = *((const f32x4*)gv_ + ln_ + 64 * j), bb = *((const f32x4*)bv_ + ln_ + 64 * j); \
                f32x4 sv, tv; if (WRITE_H) { sv = *((const f32x4*)scp + ln_ + 64 * j) + 1.0f; tv = *((const f32x4*)shp + ln_ + 64 * j); } \
                _Pragma("unroll") for (int q = 0; q < 2; ++q) { const f32x4 y = v[q][j] * rstd[q] * gg + bb; \
                    if (WRITE_X) ((f32x4*)(xc_ + (size_t)(m + q) * DM) + ln_)[64 * j] = y; \
                    if (WRITE_H) { const f32x4 h = y * sv + tv; u32x2 w; w.x = pk2(h[0], h[1]); w.y = pk2(h[2], h[3]); ((u32x2*)(hb_ + (size_t)(m + q) * DM) + ln_)[64 * j] = w; } } } } } while (0)
        DUP(1) if (ON(10)) LN_PHASE(ln_mix_g + l * DM, ln_mix_b + l * DM, modl + 3 * 2048, modl + 4 * 2048, true, false);
        GBAR();
        DUP(3) if (ON(11)) { pg8::Gemm g{Hb, Wup + (size_t)l * 2 * DFF * DM, M, 2 * DFF, DM}; pg8::StaticOrder S; S.init(M, 2 * DFF, G, bid);
          pg8::EpiUp E{ptab, l, (LAS unsigned char*)lds + LDS_HALO};
          pg8::gemm_phase<pg8::EpiUp, pg8::StaticOrder, true, true>((LAS unsigned char*)lds, g, S, E); }
        GBAR();
        if (ON(12)) {
            const float* cw = ffn_conv_w + (size_t)l * 3 * 2 * DFF; const float* cb = ffn_conv_b + (size_t)l * 2 * DFF; const float* ub_ = ubuf; bf16_t* act_ = Actb;
            for (int i = bid * 512 + tid; i < 64 * 2 * (DFF / 4); i += G * 512) { const int pm = i / (2 * (DFF / 4)), rem = i % (2 * (DFF / 4)), r = rem / (DFF / 4), c4 = (rem % (DFF / 4)) * 4;
                if ((pm & 7) == 0) continue;
                f32x4 y[2];
#pragma unroll
                for (int hf = 0; hf < 2; ++hf) { const float* up = ub_ + ((size_t)((pm - 1) * 4) * 2 + hf) * DFF + c4; const float* uc = ub_ + ((size_t)(pm * 4) * 2 + hf) * DFF + c4;
                    const f32x4 um2 = *(const f32x4*)(up + (size_t)2 * 2 * DFF), um1 = *(const f32x4*)(up + (size_t)3 * 2 * DFF), u0 = *(const f32x4*)(uc), u1 = *(const f32x4*)(uc + (size_t)2 * DFF);
                    const int ci = hf * DFF + c4; const f32x4 w0 = *(const f32x4*)(cw + ci), w1 = *(const f32x4*)(cw + 2 * DFF + ci), w2 = *(const f32x4*)(cw + 4 * DFF + ci), b4 = *(const f32x4*)(cb + ci);
                    y[hf] = (r == 0) ? (w0 * um2 + w1 * um1 + w2 * u0 + b4) : (w0 * um1 + w1 * u0 + w2 * u1 + b4); }
                float o[4];
#pragma unroll
                for (int e = 0; e < 4; ++e) { const float gq = y[0][e]; o[e] = gq / (1.f + expf(-gq)) * y[1][e]; }
                u32x2 w; w.x = pk2(o[0], o[1]); w.y = pk2(o[2], o[3]); *(u32x2*)(act_ + (size_t)(pm * 256 + r) * DFF + c4) = w; }
        }
        GBAR();
        DUP(7) if (ON(13)) { pg8::Gemm g{Actb, Wdn + (size_t)l * DM * DFF, M, DM, DFF}; pg8::StaticOrder S; S.init(M, DM, G, bid);
          pg8::EpiZ E{ptab, l, 1};
          pg8::gemm_phase<pg8::EpiZ, pg8::StaticOrder, true, true>((LAS unsigned char*)lds, g, S, E); }
        GBAR();
        DUP(1) if (!ON(14)) {} else if (l == 0) { LN_PHASE(ln_ffn_g, ln_ffn_b, mod + (size_t)8 * 12288, mod + (size_t)8 * 12288 + 2048, true, false); GBAR(); }
        else { LN_PHASE(ln_ffn_g + DM, ln_ffn_b + DM, mod, mod, false, true); }
    }
}

extern "C" void kernel_launch(void* const* d_in, const int* in_sizes, int n_in, void* d_out, int out_size, void* d_ws, size_t ws_size, hipStream_t stream) {
    static int grid = 0;
    if (grid == 0) {
        if (n_in != 19 || out_size != M * DM || ws_size < WS_END) { fprintf(stderr, "kernel_launch: unexpected shapes (n_in %d out %d ws %zu)\n", n_in, out_size, ws_size); grid = -1; return; }
        int dev = 0, cus = 0, per_cu = 0;
        (void)hipGetDevice(&dev); (void)hipDeviceGetAttribute(&cus, hipDeviceAttributeMultiprocessorCount, dev);
        if (hipFuncSetAttribute((const void*)fwd_kernel, hipFuncAttributeMaxDynamicSharedMemorySize, LDS_BYTES) != hipSuccess) { fprintf(stderr, "kernel_launch: hipFuncSetAttribute failed\n"); grid = -1; return; }
        if (hipOccupancyMaxActiveBlocksPerMultiprocessor(&per_cu, (const void*)fwd_kernel, 512, LDS_BYTES) != hipSuccess || per_cu < 1) { fprintf(stderr, "kernel_launch: occupancy query says %d\n", per_cu); per_cu = 1; }
        (void)hipGetLastError();
        if (cus != 256) fprintf(stderr, "kernel_launch: %d CUs (built for 256)\n", cus);
        grid = 256;
    }
    if (grid < 0) return;
    if (hipMemsetAsync(d_ws, 0, 16384, stream) != hipSuccess) { fprintf(stderr, "kernel_launch: memset failed\n"); return; }
    Args a{};
    for (int i = 0; i < 19; ++i) a.in[i] = d_in[i];
    a.out = (float*)d_out; a.ws = (unsigned char*)d_ws;
    void* params[] = {&a};
    const hipError_t e = hipLaunchCooperativeKernel((const void*)fwd_kernel, dim3(grid), dim3(512), params, LDS_BYTES, stream);
    if (e != hipSuccess) fprintf(stderr, "kernel_launch: cooperative launch failed: %s\n", hipGetErrorString(e));
}
```
